# Optimizing an MI355X kernel written in HIP

```python
import jax, jax.numpy as jnp
from jax import lax
import numpy as np

D_MODEL = 2048
BATCH = 4
SEQ = 4096
DEPTH = 1

N_META = 16
D_ATT = D_MODEL // 2
D_MLSTM = D_MODEL - D_ATT
ATT_HEADS = 8
QK_NOPE = 128
QK_ROPE = 64
V_HEAD = D_ATT // ATT_HEADS
Q_LORA = D_MODEL // 4
KV_LORA = D_MODEL // 8
MLSTM_HEADS = 4
MLSTM_HEAD = D_MLSTM // MLSTM_HEADS
CONV_K = 5
CHUNK = 64
META_PAD = (-N_META) % CHUNK
D_FF = 256 * ((8 * D_MODEL // 3 + 255) // 256)
D_IN = Q_LORA + KV_LORA + QK_ROPE + 2 * D_MLSTM
Q_BLOCK = 128
ROPE_BASE = 10000.0
LN_EPS = 1e-5
RMS_EPS = 1e-6
NEG = -1e30
ALPHA = (2 * DEPTH) ** 0.25
BETA = (8 * DEPTH) ** -0.25

kernel_name = 'hybrid_mla_mlstm_macaron_deepnorm_layer'


def _layer_norm(x, g, b):
    xf = x.astype(jnp.float32)
    mu = xf.mean(-1, keepdims=True)
    var = jnp.mean(jnp.square(xf - mu), -1, keepdims=True)
    return ((xf - mu) * lax.rsqrt(var + LN_EPS) * g + b).astype(x.dtype)


def _rms_norm(x, g):
    xf = x.astype(jnp.float32)
    return (xf * lax.rsqrt(jnp.mean(jnp.square(xf), -1, keepdims=True) + RMS_EPS) * g).astype(x.dtype)


def _swiglu(x, w_gate, w_up, w_down):
    return (jax.nn.silu(x @ w_gate) * (x @ w_up)) @ w_down


def _rope_tables(L):
    pos = jnp.arange(L, dtype=jnp.float32)
    inv = ROPE_BASE ** (-jnp.arange(0, QK_ROPE, 2, dtype=jnp.float32) / QK_ROPE)
    ang = pos[:, None] * inv[None, :]
    return jnp.cos(ang), jnp.sin(ang)


def _apply_rope(x, cos, sin):
    xf = x.astype(jnp.float32)
    x1, x2 = jnp.split(xf, 2, axis=-1)
    c, s = cos[:, None, :], sin[:, None, :]
    return jnp.concatenate([x1 * c - x2 * s, x2 * c + x1 * s], -1).astype(x.dtype)


def _mla(u_q, u_kv, u_kr, q_norm_g, w_uq, kv_norm_g, w_ukv, out_g, cos, sin):
    B, L, _ = u_q.shape
    H = ATT_HEADS
    q = (_rms_norm(u_q, q_norm_g) @ w_uq).reshape(B, L, H, QK_NOPE + QK_ROPE)
    q_nope, q_rope = q[..., :QK_NOPE], _apply_rope(q[..., QK_NOPE:], cos, sin)
    kv = (_rms_norm(u_kv, kv_norm_g) @ w_ukv).reshape(B, L, H, QK_NOPE + V_HEAD)
    k_nope, v = kv[..., :QK_NOPE], kv[..., QK_NOPE:]
    k_rope = _apply_rope(u_kr[:, :, None, :], cos, sin)[:, :, 0]
    scale = (QK_NOPE + QK_ROPE) ** -0.5
    n_blk = -(-L // Q_BLOCK)
    pad = n_blk * Q_BLOCK - L

    def to_blocks(a):
        a = jnp.pad(a, ((0, 0), (0, pad), (0, 0), (0, 0)))
        return a.reshape(B, n_blk, Q_BLOCK, H, a.shape[-1]).transpose(1, 0, 2, 3, 4)

    def block(args):
        qn_b, qr_b = args
        s = (jnp.einsum('bqhd,bkhd->bhqk', qn_b, k_nope)
             + jnp.einsum('bqhd,bkd->bhqk', qr_b, k_rope))
        p = jax.nn.softmax(s.astype(jnp.float32) * scale, axis=-1).astype(v.dtype)
        return jnp.einsum('bhqk,bkhd->bqhd', p, v)

    o = lax.map(block, (to_blocks(q_nope), to_blocks(q_rope)))
    o = o.transpose(1, 0, 2, 3, 4).reshape(B, n_blk * Q_BLOCK, H * V_HEAD)[:, :L]
    return _rms_norm(o, out_g)


def _mlstm_chunkwise(q, k, v, li, lf):
    B, H, T, dk = q.shape
    dv = v.shape[-1]
    nc = T // CHUNK
    mask = jnp.tril(jnp.ones((CHUNK, CHUNK), bool))

    def to_chunks(a):
        return jnp.moveaxis(a.reshape(B, H, nc, CHUNK, *a.shape[3:]), 2, 0)

    def step(carry, xs):
        C, n, m = carry
        qc, kc, vc, lic, lfc = xs
        b = jnp.cumsum(lfc, -1)
        D = jnp.where(mask, b[..., :, None] - b[..., None, :] + lic[..., None, :], NEG)
        m_inter = b + m[..., None]
        m_t = jnp.maximum(m_inter, D.max(-1))
        A = jnp.exp(D - m_t[..., None]) * jnp.einsum('bhtd,bhsd->bhts', qc, kc)
        w_inter = jnp.exp(m_inter - m_t)
        num = (jnp.einsum('bhts,bhsv->bhtv', A, vc)
               + w_inter[..., None] * jnp.einsum('bhtd,bhdv->bhtv', qc, C))
        den = A.sum(-1) + w_inter * jnp.einsum('bhtd,bhd->bht', qc, n)
        h = num / jnp.maximum(jnp.abs(den), jnp.exp(-m_t))[..., None]
        bL = b[..., -1]
        g = bL[..., None] - b + lic
        m_new = jnp.maximum(bL + m, g.max(-1))
        decay = jnp.exp(bL + m - m_new)
        wc = jnp.exp(g - m_new[..., None])
        C = decay[..., None, None] * C + jnp.einsum('bhs,bhsd,bhsv->bhdv', wc, kc, vc)
        n = decay[..., None] * n + jnp.einsum('bhs,bhsd->bhd', wc, kc)
        return (C, n, m_new), h

    init = (jnp.zeros((B, H, dk, dv), jnp.float32), jnp.zeros((B, H, dk), jnp.float32),
            jnp.zeros((B, H), jnp.float32))
    _, h = lax.scan(step, init, tuple(to_chunks(a) for a in (q, k, v, li, lf)))
    return jnp.moveaxis(h, 0, 2).reshape(B, H, T, dv)


def _centred_dwconv(x, w, b):
    K = w.shape[0]
    y = lax.conv_general_dilated(x, w[:, None, :].astype(x.dtype), window_strides=(1,),
                                 padding=[(K // 2, K // 2)], dimension_numbers=('NWC', 'WIO', 'NWC'),
                                 feature_group_count=x.shape[-1])
    return y + b


def _mlstm_mixer(x_m, z, conv_w, conv_b, w_q, w_k, w_v, w_gates, b_gates, gn_g, skip):
    B, L, _ = x_m.shape
    H, dh = MLSTM_HEADS, MLSTM_HEAD
    f32 = jnp.float32
    x_c = jax.nn.silu(_centred_dwconv(x_m, conv_w, conv_b))
    xc_h = x_c.reshape(B, L, H, dh)
    xm_h = x_m.reshape(B, L, H, dh)
    q = jnp.einsum('blhd,hde->bhle', xc_h, w_q).astype(f32)
    k = (jnp.einsum('blhd,hde->bhle', xc_h, w_k) * dh ** -0.5).astype(f32)
    v = jnp.einsum('blhd,hde->bhle', xm_h, w_v).astype(f32)
    g = (jnp.concatenate([x_c, x_m], -1) @ w_gates + b_gates).astype(f32)
    g = g.reshape(B, L, 4, H).transpose(2, 0, 3, 1)
    tpad = ((0, 0), (0, 0), (META_PAD, 0))
    pad4 = tpad + ((0, 0),)
    q, k, v = [jnp.pad(a, pad4) for a in (q, k, v)]
    li_f = jnp.pad(g[0], tpad, constant_values=NEG)
    lf_f = jnp.pad(jax.nn.log_sigmoid(g[1]), tpad)
    li_b = jnp.pad(g[2], tpad, constant_values=NEG)
    lf_b = jnp.pad(jax.nn.log_sigmoid(g[3]), tpad)
    h_f = _mlstm_chunkwise(q, k, v, li_f, lf_f)
    flip = lambda a: jnp.flip(a, axis=2)
    h_b = flip(_mlstm_chunkwise(flip(q), flip(k), flip(v), flip(li_b), flip(lf_b)))
    h = (h_f + h_b)[:, :, META_PAD:].transpose(0, 2, 1, 3)
    h = jax.nn.sigmoid(z.astype(f32)).reshape(B, L, H, dh) * h
    mu = h.mean(-1, keepdims=True)
    var = jnp.mean(jnp.square(h - mu), -1, keepdims=True)
    h = ((h - mu) * lax.rsqrt(var + LN_EPS)).reshape(B, L, D_MLSTM)
    return (h * gn_g + skip * x_c).astype(x_m.dtype)


def _normal(key, shape, scale):
    return scale * jax.random.normal(key, shape, jnp.float32)


def setup_inputs(seed: int = 0) -> dict:
    key = jax.random.key(seed)
    ks = iter(jax.random.split(key, 40))

    def w(shape, fan_in, mult=1.0):
        return _normal(next(ks), (DEPTH,) + shape, mult * fan_in ** -0.5)

    def gain(n):
        return 1.0 + _normal(next(ks), (DEPTH, n), 0.02)

    def bias(n):
        return _normal(next(ks), (DEPTH, n), 0.02)

    H = MLSTM_HEADS
    x = _normal(next(ks), (BATCH, SEQ, D_MODEL), 1.0)
    meta_tokens = _normal(next(ks), (N_META, D_MODEL), 1.0)
    ffn1_w_gate = w((D_MODEL, D_FF), D_MODEL)
    ffn1_w_up = w((D_MODEL, D_FF), D_MODEL)
    ffn1_w_down = w((D_FF, D_MODEL), D_FF, BETA)
    ln1_g, ln1_b = gain(D_MODEL), bias(D_MODEL)
    w_in = w((D_MODEL, D_IN), D_MODEL)
    mla_q_norm_g = gain(Q_LORA)
    mla_w_uq = w((Q_LORA, ATT_HEADS * (QK_NOPE + QK_ROPE)), Q_LORA)
    mla_kv_norm_g = gain(KV_LORA)
    mla_w_ukv = w((KV_LORA, ATT_HEADS * (QK_NOPE + V_HEAD)), KV_LORA)
    attn_out_g = gain(D_ATT)
    mlstm_conv_w = w((CONV_K, D_MLSTM), CONV_K)
    mlstm_conv_b = bias(D_MLSTM)
    mlstm_w_q = w((H, MLSTM_HEAD, MLSTM_HEAD), MLSTM_HEAD)
    mlstm_w_k = w((H, MLSTM_HEAD, MLSTM_HEAD), MLSTM_HEAD)
    mlstm_w_v = w((H, MLSTM_HEAD, MLSTM_HEAD), MLSTM_HEAD)
    mlstm_w_gates = w((2 * D_MLSTM, 4 * H), 2 * D_MLSTM)
    i_bias = _normal(next(ks), (DEPTH, 2, H), 0.1)
    f_bias = jnp.linspace(3.0, 6.0, H, dtype=jnp.float32)[None, None, :] + _normal(next(ks), (DEPTH, 2, H), 0.1)
    mlstm_b_gates = jnp.stack([i_bias, f_bias], axis=2).reshape(DEPTH, 4 * H)
    mlstm_gn_g = gain(D_MLSTM)
    mlstm_skip = gain(D_MLSTM)
    w_out = w((D_MODEL, D_MODEL), D_MODEL, BETA)
    ln2_g, ln2_b = gain(D_MODEL), bias(D_MODEL)
    ffn2_w_gate = w((D_MODEL, D_FF), D_MODEL)
    ffn2_w_up = w((D_MODEL, D_FF), D_MODEL)
    ffn2_w_down = w((D_FF, D_MODEL), D_FF, BETA)
    ln3_g, ln3_b = gain(D_MODEL), bias(D_MODEL)
    return {'x': x, 'meta_tokens': meta_tokens,
            'ffn1_w_gate': ffn1_w_gate, 'ffn1_w_up': ffn1_w_up, 'ffn1_w_down': ffn1_w_down,
            'ln1_g': ln1_g, 'ln1_b': ln1_b, 'w_in': w_in,
            'mla_q_norm_g': mla_q_norm_g, 'mla_w_uq': mla_w_uq, 'mla_kv_norm_g': mla_kv_norm_g,
            'mla_w_ukv': mla_w_ukv, 'attn_out_g': attn_out_g,
            'mlstm_conv_w': mlstm_conv_w, 'mlstm_conv_b': mlstm_conv_b, 'mlstm_w_q': mlstm_w_q,
            'mlstm_w_k': mlstm_w_k, 'mlstm_w_v': mlstm_w_v, 'mlstm_w_gates': mlstm_w_gates,
            'mlstm_b_gates': mlstm_b_gates, 'mlstm_gn_g': mlstm_gn_g, 'mlstm_skip': mlstm_skip,
            'w_out': w_out, 'ln2_g': ln2_g, 'ln2_b': ln2_b,
            'ffn2_w_gate': ffn2_w_gate, 'ffn2_w_up': ffn2_w_up, 'ffn2_w_down': ffn2_w_down,
            'ln3_g': ln3_g, 'ln3_b': ln3_b}


def reference(x, meta_tokens, ffn1_w_gate, ffn1_w_up, ffn1_w_down, ln1_g, ln1_b, w_in,
              mla_q_norm_g, mla_w_uq, mla_kv_norm_g, mla_w_ukv, attn_out_g,
              mlstm_conv_w, mlstm_conv_b, mlstm_w_q, mlstm_w_k, mlstm_w_v, mlstm_w_gates,
              mlstm_b_gates, mlstm_gn_g, mlstm_skip, w_out, ln2_g, ln2_b,
              ffn2_w_gate, ffn2_w_up, ffn2_w_down, ln3_g, ln3_b):
    B = x.shape[0]
    meta = jnp.broadcast_to(meta_tokens[None].astype(x.dtype), (B, N_META, x.shape[-1]))
    h = jnp.concatenate([meta, x], axis=1)
    L = h.shape[1]
    cos, sin = _rope_tables(L)
    o1 = Q_LORA
    o2 = o1 + KV_LORA
    o3 = o2 + QK_ROPE
    o4 = o3 + D_MLSTM
    for d in range(DEPTH):
        h = _layer_norm(ALPHA * h + 0.5 * _swiglu(h, ffn1_w_gate[d], ffn1_w_up[d], ffn1_w_down[d]), ln1_g[d], ln1_b[d])
        u = h @ w_in[d]
        y_att = _mla(u[..., :o1], u[..., o1:o2], u[..., o2:o3], mla_q_norm_g[d], mla_w_uq[d],
                     mla_kv_norm_g[d], mla_w_ukv[d], attn_out_g[d], cos, sin)
        y_mlstm = _mlstm_mixer(u[..., o3:o4], u[..., o4:], mlstm_conv_w[d], mlstm_conv_b[d],
                               mlstm_w_q[d], mlstm_w_k[d], mlstm_w_v[d], mlstm_w_gates[d],
                               mlstm_b_gates[d], mlstm_gn_g[d], mlstm_skip[d])
        y = jnp.concatenate([y_att, y_mlstm], axis=-1) @ w_out[d]
        h = _layer_norm(ALPHA * h + y, ln2_g[d], ln2_b[d])
        h = _layer_norm(ALPHA * h + 0.5 * _swiglu(h, ffn2_w_gate[d], ffn2_w_up[d], ffn2_w_down[d]), ln3_g[d], ln3_b[d])
    return h[:, N_META:]
```

```cpp
#include <hip/hip_runtime.h>
#include <hip/hip_cooperative_groups.h>
#include <cstdio>
#include <cstdint>
namespace cg = cooperative_groups;
#ifndef GEMM_SP2
#define GEMM_SP2 true
#endif
#ifndef GEMM_ALIGN
#define GEMM_ALIGN true
#endif

#define LAS __attribute__((address_space(3)))
typedef unsigned short bf16_t;
typedef short bf16x8 __attribute__((ext_vector_type(8)));
typedef short s16x4 __attribute__((ext_vector_type(4)));
typedef float f32x4 __attribute__((ext_vector_type(4)));
typedef float f32x2 __attribute__((ext_vector_type(2)));
typedef float f32x16 __attribute__((ext_vector_type(16)));
typedef unsigned u32x4 __attribute__((ext_vector_type(4)));
typedef unsigned u32x2 __attribute__((ext_vector_type(2)));

constexpr int DM = 2048, FF = 5632, TR = 16384, MR = 16640, MROWS = 16448, SEQ = 4096, LK = 4160, LTOT = 4112;
constexpr int UW = 3072, O2 = 512, O3 = 768, O4 = 832, O5 = 1856;
constexpr float ALPHA = 1.189207115002721f;
constexpr float QSCALE = 0.07216878364870322f * 1.4426950408889634f;
constexpr int LDS_BYTES = 147456;
constexpr int NTHR = 512;

constexpr size_t WS_CTL = 0;
constexpr size_t WS_BAR = 4096;
constexpr size_t WS_ROPE = 4096 + 16384;
constexpr size_t WS_ZMETA = WS_ROPE + 1052672;
constexpr size_t WS_WIN = WS_ZMETA + 2097152;
constexpr size_t WS_WUQ = WS_WIN + 12582912;
constexpr size_t WS_WK = WS_WUQ + 1572864;
constexpr size_t WS_WV = WS_WK + 524288;
constexpr size_t WS_WMQ = WS_WV + 524288;
constexpr size_t WS_WMK = WS_WMQ + 524288;
constexpr size_t WS_WMV = WS_WMK + 524288;
constexpr size_t WS_WOUT = WS_WMV + 524288;
constexpr size_t WS_KROPE = WS_WOUT + 8388608;
constexpr size_t WS_RW = WS_KROPE + 2129920;
constexpr size_t WS_WGU = WS_RW, WS_WD = WS_RW + 46137344;
constexpr size_t WS_QN = WS_RW, WS_KVN = WS_QN + 17039360, WS_XC = WS_KVN + 8519680, WS_GATES = WS_XC + 34078720;
constexpr size_t WS_RH0 = WS_RW + 69206016;
constexpr size_t WS_H0 = WS_RH0, WS_KN = WS_RH0, WS_VT = WS_RH0 + 34078720, WS_H2 = WS_RH0;
constexpr size_t WS_RG = WS_RH0 + 68157440;
constexpr size_t WS_G = WS_RG, WS_U = WS_RG, WS_OATT = WS_U + 102236160, WS_MKT = WS_OATT + 33554432;
constexpr size_t WS_H1 = WS_RG + 187432960;
constexpr size_t WS_RM = WS_H1 + 68157440;
constexpr size_t WS_MQ = WS_RM, WS_MK = WS_MQ + 34078720, WS_MVT = WS_MK + 34078720, WS_YCAT = WS_RM;
constexpr size_t WS_WGT = WS_RM + 102236160;
constexpr size_t WS_TAB = WS_WGT + 65536;
constexpr size_t WS_WMKN = WS_TAB + 64 * 129 * 512;
constexpr size_t WS_END = WS_WMKN + 524288;
static_assert(WS_MKT + 34078720 <= WS_H1, "RG overlay");
static_assert(WS_GATES + 1064960 <= WS_RH0, "RW overlay");
static_assert(WS_END <= 536870912ull, "workspace");
constexpr size_t DO_Q = 0, DO_HF = 50331648, DO_HB = DO_HF + 33554432;

__device__ __forceinline__ unsigned f2bf(float f) { unsigned u = __builtin_bit_cast(unsigned, f); return (u + 0x7fffu + ((u >> 16) & 1u)) >> 16; }
typedef __bf16 bf16x2_t __attribute__((ext_vector_type(2)));
__device__ __forceinline__ unsigned cvtpk(float lo, float hi) { const f32x2 v = {lo, hi}; const bf16x2_t b = __builtin_convertvector(v, bf16x2_t); return __builtin_bit_cast(unsigned, b); }
__device__ __forceinline__ unsigned pk2(float lo, float hi) { return cvtpk(lo, hi); }
__device__ __forceinline__ float bflo(unsigned u) { return __builtin_bit_cast(float, u << 16); }
__device__ __forceinline__ float bfhi(unsigned u) { return __builtin_bit_cast(float, u & 0xffff0000u); }
__device__ __forceinline__ float bf1(bf16_t h) { return __builtin_bit_cast(float, (unsigned)h << 16); }
__device__ __forceinline__ float wave_sum(float v) {
#pragma unroll
    for (int o = 1; o < 64; o <<= 1) v += __shfl_xor(v, o);
    return v;
}
__device__ __forceinline__ float siluf(float x) { return x * __builtin_amdgcn_rcpf(1.f + __builtin_amdgcn_exp2f(-1.4426950408889634f * x)); }
__device__ __forceinline__ float sigmf(float x) { return __builtin_amdgcn_rcpf(1.f + __builtin_amdgcn_exp2f(-1.4426950408889634f * x)); }
__device__ __forceinline__ int lane_id_v() { int l; asm volatile("v_mbcnt_lo_u32_b32 %0, -1, 0\n\tv_mbcnt_hi_u32_b32 %0, -1, %0" : "=v"(l)); return l; }
__device__ __forceinline__ float shx(float v, int lane, int m) { return __builtin_bit_cast(float, __builtin_amdgcn_ds_bpermute((lane ^ m) << 2, __builtin_bit_cast(int, v))); }
__device__ __forceinline__ float shl(float v, int src) { return __builtin_bit_cast(float, __builtin_amdgcn_ds_bpermute(src << 2, __builtin_bit_cast(int, v))); }
#define LDS_WAIT() asm volatile("s_waitcnt lgkmcnt(0)" ::: "memory")

namespace pg8 {
constexpr int BM = 256, BK = 64, HALF = 128, HTB = HALF * BK * 2, STAGE_BYTES = 8 * HTB, NXCD = 8, WGM = 8;
__host__ __device__ __forceinline__ int lds_byte(int r, int c) { const int st = (r >> 4) * 2 + (c >> 5), rr = r & 15, cc = c & 31, ob = rr * 64 + cc * 2; return st * 1024 + (ob ^ (((ob >> 9) & 1) << 5)); }
__host__ __device__ __forceinline__ void stage_rc(int b, int& R, int& C) { const int st = b / 1024, sb = b % 1024, swz = sb ^ (((sb >> 9) & 1) << 5); R = (st >> 1) * 16 + swz / 64; C = (st & 1) * 32 + (swz % 64) / 2; }
__host__ __device__ __forceinline__ int perm32(int rho) { const int n = rho >> 4, i = rho & 15; return 8 * (i >> 2) + 4 * n + (i & 3); }

struct Unit { int pm, pn, g; const char* a; const char* b; };
__device__ __forceinline__ const char* uptr(const char* p) { const unsigned long long v = (unsigned long long)p; const unsigned lo = __builtin_amdgcn_readfirstlane((unsigned)v), hi = __builtin_amdgcn_readfirstlane((unsigned)(v >> 32)); return (const char*)(((unsigned long long)hi << 32) | lo); }
struct Gemm { int K, lda, ldb; };

struct Sched {
    int nM, nN, nwg, total, G, c; const char* A0; const char* B0; size_t aG, bG, tA, tB; int gmodA;
    __device__ void init(int nM_, int nN_, int ngrp, int G_, int c_, const void* A0_, const void* B0_, size_t aG_, size_t bG_, int gmodA_, int lda, int ldb) {
        nM = nM_; nN = nN_; nwg = nM * nN; total = nwg * ngrp; G = G_; c = c_; A0 = (const char*)A0_; B0 = (const char*)B0_; aG = aG_; bG = bG_; gmodA = gmodA_;
        tA = (size_t)256 * lda * 2; tB = (size_t)256 * ldb * 2;
    }
    __device__ bool next(int i, Unit& u) const {
        const int L = i * G + c; if (L >= total) return false;
        const int g = L / nwg; int wgid = L - g * nwg;
        { const int q = nwg / NXCD, r = nwg % NXCD, xcd = wgid % NXCD, off = wgid / NXCD; wgid = (xcd < r ? xcd * (q + 1) : r * (q + 1) + (xcd - r) * q) + off; }
        const int nig = WGM * nN, gid = wgid / nig, fm = gid * WGM, gsz = (nM - fm) < WGM ? (nM - fm) : WGM;
        u.pm = __builtin_amdgcn_readfirstlane(fm + ((wgid % nig) % gsz)); u.pn = __builtin_amdgcn_readfirstlane((wgid % nig) / gsz); u.g = __builtin_amdgcn_readfirstlane(g);
        u.a = uptr(A0 + (size_t)(u.g % gmodA) * aG + (size_t)u.pm * tA); u.b = uptr(B0 + (size_t)u.g * bG + (size_t)u.pn * tB);
        return true;
    }
};

__device__ __forceinline__ unsigned cvt_pk_bf16(float lo, float hi) { unsigned r; asm volatile("v_cvt_pk_bf16_f32 %0, %1, %2" : "=v"(r) : "v"(lo), "v"(hi)); return r; }

template <bool SP2, bool ALIGN_EPI, class Epi>
__device__ __forceinline__ void gemm_phase(LAS unsigned char* lds, const Gemm g, const Sched& S, const Epi& E, int wave_u) {
    int tid = wave_u * 64 + lane_id_v();
    const int wid = __builtin_amdgcn_readfirstlane(tid >> 6), lane = tid & 63, wr = wid >> 2, wc = wid & 3, fr = lane & 15, fq = lane >> 4;
    const int K = g.K, nt = K / BK;
    unsigned voffA[2], voffB[2];
#pragma unroll
    for (int i = 0; i < 2; ++i) { int R, C; stage_rc(tid * 16 + i * 8192, R, C); const int Rb = (R & ~31) + perm32(R & 31);
        voffA[i] = (unsigned)(R * g.lda + C) * 2u; voffB[i] = (unsigned)(Rb * g.ldb + C) * 2u; }
    const size_t kstep = (size_t)(BK * 2);
    const size_t hstepA = (size_t)HALF * g.lda * 2, hstepB = (size_t)HALF * g.ldb * 2;
    const unsigned ldsw = (unsigned)wid * 1024u;
    const int aoff = lds_byte(wr * 64 + fr, fq * 8), boff = lds_byte(wc * 32 + fr, fq * 8);
#define PG8_SA(b, h) (((b) * 2 + (h)) * HTB)
#define PG8_SB(b, h) ((4 + (b) * 2 + (h)) * HTB)
#define PG8_STAGE(bufoff, gbase, voff) do { _Pragma("unroll") for (int _i = 0; _i < 2; ++_i) \
        __builtin_amdgcn_global_load_lds((const unsigned*)((const char*)(gbase) + (voff)[_i]), (LAS unsigned*)(lds + (bufoff) + ldsw + _i * 8192), 16, 0, 0); } while (0)
#define PG8_LDA(dst, b, h) do { _Pragma("unroll") for (int m = 0; m < 4; ++m) _Pragma("unroll") for (int k = 0; k < 2; ++k) dst[m][k] = *(const LAS bf16x8*)(lds + PG8_SA(b, h) + aoff + m * 2048 + k * 1024); } while (0)
#define PG8_LDB(dst, b, h) do { _Pragma("unroll") for (int n = 0; n < 2; ++n) _Pragma("unroll") for (int k = 0; k < 2; ++k) dst[n][k] = *(const LAS bf16x8*)(lds + PG8_SB(b, h) + boff + n * 2048 + k * 1024); } while (0)
#define PG8_MMA(ai, bj, At, Bt) do { __builtin_amdgcn_s_setprio(1); _Pragma("unroll") for (int m = 0; m < 4; ++m) _Pragma("unroll") for (int n = 0; n < 2; ++n) _Pragma("unroll") for (int k = 0; k < 2; ++k) \
        acc[ai][bj][m][n] = __builtin_amdgcn_mfma_f32_16x16x32_bf16(Bt[n][k], At[m][k], acc[ai][bj][m][n], 0, 0, 0); __builtin_amdgcn_s_setprio(0); } while (0)
#define PG8_WAIT_V(n) asm volatile("s_waitcnt vmcnt(" #n ")" ::: "memory")
#define PG8_WAIT_L(n) asm volatile("s_waitcnt lgkmcnt(" #n ")" ::: "memory")
#define PG8_BAR __builtin_amdgcn_s_barrier()
#define PG8_SCHED __builtin_amdgcn_sched_barrier(0)
    Unit cur, nxt; int ui = 0;
    if (!S.next(0, cur)) return;
    f32x4 acc[2][2][4][2];
#pragma unroll
    for (int a = 0; a < 2; ++a)
#pragma unroll
        for (int b = 0; b < 2; ++b)
#pragma unroll
            for (int m = 0; m < 4; ++m)
#pragma unroll
                for (int n = 0; n < 2; ++n) acc[a][b][m][n] = (f32x4){0.f, 0.f, 0.f, 0.f};
    bf16x8 At[4][2], B0[2][2], B1[2][2];
    const char* cA = cur.a; const char* cB = cur.b;
    if constexpr (SP2) {
        PG8_STAGE(PG8_SB(0, 0), cB, voffB); PG8_STAGE(PG8_SB(0, 1), cB + hstepB, voffB); PG8_STAGE(PG8_SA(0, 0), cA, voffA); PG8_STAGE(PG8_SA(0, 1), cA + hstepA, voffA);
        if (wr == 1) PG8_BAR;
        PG8_WAIT_V(2); PG8_BAR;
        PG8_STAGE(PG8_SB(1, 0), cB + kstep, voffB); PG8_STAGE(PG8_SA(1, 0), cA + kstep, voffA); PG8_STAGE(PG8_SB(1, 1), cB + hstepB + kstep, voffB);
        PG8_WAIT_V(6); PG8_BAR;
    } else {
        PG8_STAGE(PG8_SB(0, 0), cB, voffB); PG8_STAGE(PG8_SA(0, 0), cA, voffA); PG8_STAGE(PG8_SB(0, 1), cB + hstepB, voffB); PG8_STAGE(PG8_SA(0, 1), cA + hstepA, voffA);
        if (wr == 1) PG8_BAR;
        PG8_WAIT_V(4); PG8_BAR;
        PG8_STAGE(PG8_SB(1, 0), cB + kstep, voffB); PG8_STAGE(PG8_SA(1, 0), cA + kstep, voffA); PG8_STAGE(PG8_SB(1, 1), cB + hstepB + kstep, voffB);
        PG8_WAIT_V(6); PG8_BAR;
    }
    for (;;) {
        const bool has_next = S.next(ui + 1, nxt);
        const char* nA = has_next ? nxt.a : cA; const char* nB = has_next ? nxt.b : cB;
#pragma unroll 1
        for (int t = 0; t < nt; t += 2) {
            const bool last = (t == nt - 2);
            const char* a1 = cA + (size_t)(t + 1) * kstep;
            const char* a2 = last ? nA : cA + (size_t)(t + 2) * kstep; const char* b2 = last ? nB : cB + (size_t)(t + 2) * kstep;
            const char* a3 = a2 + kstep; const char* b3 = b2 + kstep;
            if constexpr (SP2) {
            PG8_LDB(B0, 0, 0); PG8_LDB(B1, 0, 1); PG8_SCHED; PG8_LDA(At, 0, 0); PG8_STAGE(PG8_SA(1, 1), a1 + hstepA, voffA);
            PG8_WAIT_V(8); PG8_WAIT_L(0); PG8_BAR; PG8_MMA(0, 0, At, B0); PG8_MMA(0, 1, At, B1); PG8_BAR; PG8_SCHED;
            PG8_LDA(At, 0, 1); PG8_STAGE(PG8_SB(0, 0), b2, voffB); PG8_STAGE(PG8_SB(0, 1), b2 + hstepB, voffB); PG8_STAGE(PG8_SA(0, 0), a2, voffA);
            PG8_WAIT_V(8); PG8_WAIT_L(0); PG8_BAR; PG8_MMA(1, 0, At, B0); PG8_MMA(1, 1, At, B1); PG8_BAR; PG8_SCHED;
            PG8_LDB(B0, 1, 0); PG8_LDB(B1, 1, 1); PG8_SCHED; PG8_LDA(At, 1, 0); PG8_STAGE(PG8_SA(0, 1), a2 + hstepA, voffA);
            PG8_WAIT_V(8); PG8_WAIT_L(0); PG8_BAR; PG8_MMA(0, 0, At, B0); PG8_MMA(0, 1, At, B1); PG8_BAR; PG8_SCHED;
            PG8_LDA(At, 1, 1); PG8_STAGE(PG8_SB(1, 0), b3, voffB); PG8_STAGE(PG8_SB(1, 1), b3 + hstepB, voffB); PG8_STAGE(PG8_SA(1, 0), a3, voffA);
            PG8_WAIT_V(8); PG8_WAIT_L(0); PG8_BAR; PG8_MMA(1, 0, At, B0); PG8_MMA(1, 1, At, B1); PG8_BAR; PG8_SCHED;
            } else {
            PG8_LDB(B0, 0, 0); PG8_SCHED; PG8_LDA(At, 0, 0); PG8_STAGE(PG8_SA(1, 1), a1 + hstepA, voffA);
            PG8_WAIT_L(8); PG8_BAR; PG8_WAIT_L(0); PG8_MMA(0, 0, At, B0); PG8_BAR; PG8_SCHED;
            PG8_LDB(B1, 0, 1); PG8_STAGE(PG8_SB(0, 0), b2, voffB);
            PG8_BAR; PG8_WAIT_L(0); PG8_MMA(0, 1, At, B1); PG8_BAR;
            PG8_LDA(At, 0, 1); PG8_STAGE(PG8_SA(0, 0), a2, voffA);
            PG8_BAR; PG8_WAIT_L(0); PG8_MMA(1, 0, At, B0); PG8_BAR; PG8_SCHED;
            PG8_STAGE(PG8_SB(0, 1), b2 + hstepB, voffB);
            PG8_WAIT_V(6); PG8_BAR; PG8_MMA(1, 1, At, B1); PG8_BAR;
            PG8_LDB(B0, 1, 0); PG8_SCHED; PG8_LDA(At, 1, 0); PG8_STAGE(PG8_SA(0, 1), a2 + hstepA, voffA);
            PG8_WAIT_L(8); PG8_BAR; PG8_WAIT_L(0); PG8_MMA(0, 0, At, B0); PG8_BAR; PG8_SCHED;
            PG8_LDB(B1, 1, 1); PG8_STAGE(PG8_SB(1, 0), b3, voffB);
            PG8_BAR; PG8_WAIT_L(0); PG8_MMA(0, 1, At, B1); PG8_BAR;
            PG8_LDA(At, 1, 1); PG8_STAGE(PG8_SA(1, 0), a3, voffA);
            PG8_BAR; PG8_WAIT_L(0); PG8_MMA(1, 0, At, B0); PG8_BAR; PG8_SCHED;
            PG8_STAGE(PG8_SB(1, 1), b3 + hstepB, voffB);
            PG8_WAIT_V(6); PG8_BAR; PG8_MMA(1, 1, At, B1); PG8_BAR;
            }
        }
        if constexpr (ALIGN_EPI) { if (wr == 0) PG8_BAR; }
        E(acc, cur, wr, wc, fr, fq);
        if (!has_next) break;
#pragma unroll
        for (int a = 0; a < 2; ++a)
#pragma unroll
            for (int b = 0; b < 2; ++b)
#pragma unroll
                for (int m = 0; m < 4; ++m)
#pragma unroll
                    for (int n = 0; n < 2; ++n) acc[a][b][m][n] = (f32x4){0.f, 0.f, 0.f, 0.f};
        cur = nxt; cA = nA; cB = nB; ++ui;
        if constexpr (ALIGN_EPI) { if (wr == 1) PG8_BAR; }
    }
    PG8_WAIT_V(0);
    if constexpr (!ALIGN_EPI) { if (wr == 0) PG8_BAR; }
    PG8_BAR;
#undef PG8_SA
#undef PG8_SB
#undef PG8_STAGE
#undef PG8_LDA
#undef PG8_LDB
#undef PG8_MMA
#undef PG8_WAIT_V
#undef PG8_WAIT_L
#undef PG8_BAR
#undef PG8_SCHED
}

#define EPI_LOOP_ROWS for (int ai = 0; ai < 2; ++ai) for (int m = 0; m < 4; ++m, __builtin_amdgcn_sched_barrier(0))
struct EpiSwiGLU {
    bf16_t* G;
    __device__ __forceinline__ void operator()(const f32x4 (&acc)[2][2][4][2], const Unit& u, int wr, int wc, int fr, int fq) const {
        const int col = u.pn * 128 + wc * 32 + fq * 8;
#pragma unroll
        EPI_LOOP_ROWS { const int row = u.pm * 256 + ai * 128 + wr * 64 + m * 16 + fr;
            float o[8];
#pragma unroll
            for (int n = 0; n < 2; ++n)
#pragma unroll
                for (int j = 0; j < 4; ++j) o[n * 4 + j] = siluf(acc[ai][0][m][n][j]) * acc[ai][1][m][n][j];
            u32x4 w; w.x = pk2(o[0], o[1]); w.y = pk2(o[2], o[3]); w.z = pk2(o[4], o[5]); w.w = pk2(o[6], o[7]);
            *(u32x4*)(G + (size_t)row * FF + col) = w; }
    }
};
struct EpiResid {
    const bf16_t* res; bf16_t* zb; float sc;
    __device__ __forceinline__ void operator()(const f32x4 (&acc)[2][2][4][2], const Unit& u, int wr, int wc, int fr, int fq) const {
#pragma unroll
        EPI_LOOP_ROWS { const int row = u.pm * 256 + ai * 128 + wr * 64 + m * 16 + fr;
#pragma unroll
            for (int bj = 0; bj < 2; ++bj) { const int col = u.pn * 256 + bj * 128 + wc * 32 + fq * 8;
                const u32x4 rv = *(const u32x4*)(res + (size_t)row * DM + col);
                u32x4 w;
                w.x = pk2(ALPHA * bflo(rv.x) + sc * acc[ai][bj][m][0][0], ALPHA * bfhi(rv.x) + sc * acc[ai][bj][m][0][1]);
                w.y = pk2(ALPHA * bflo(rv.y) + sc * acc[ai][bj][m][0][2], ALPHA * bfhi(rv.y) + sc * acc[ai][bj][m][0][3]);
                w.z = pk2(ALPHA * bflo(rv.z) + sc * acc[ai][bj][m][1][0], ALPHA * bfhi(rv.z) + sc * acc[ai][bj][m][1][1]);
                w.w = pk2(ALPHA * bflo(rv.w) + sc * acc[ai][bj][m][1][2], ALPHA * bfhi(rv.w) + sc * acc[ai][bj][m][1][3]);
                *(u32x4*)(zb + (size_t)row * DM + col) = w; }
        }
    }
};
struct EpiBf16 {
    bf16_t* O; int ldc; size_t gstride; int gscale_from; float sc;
    __device__ __forceinline__ void operator()(const f32x4 (&acc)[2][2][4][2], const Unit& u, int wr, int wc, int fr, int fq) const {
        const float s = (u.g >= gscale_from) ? sc : 1.f;
        bf16_t* base = O + (size_t)u.g * gstride;
#pragma unroll
        EPI_LOOP_ROWS { const int row = u.pm * 256 + ai * 128 + wr * 64 + m * 16 + fr;
#pragma unroll
            for (int bj = 0; bj < 2; ++bj) { const int col = u.pn * 256 + bj * 128 + wc * 32 + fq * 8;
                const f32x4 v0 = acc[ai][bj][m][0] * s, v1 = acc[ai][bj][m][1] * s;
                u32x4 w; w.x = pk2(v0[0], v0[1]); w.y = pk2(v0[2], v0[3]); w.z = pk2(v1[0], v1[1]); w.w = pk2(v1[2], v1[3]);
                *(u32x4*)(base + (size_t)row * ldc + col) = w; }
        }
    }
};
struct EpiQ {
    bf16_t* Q; const f32x2* rope;
    __device__ __forceinline__ void operator()(const f32x4 (&acc)[2][2][4][2], const Unit& u, int wr, int wc, int fr, int fq) const {
#pragma unroll
        EPI_LOOP_ROWS { const int row = u.pm * 256 + ai * 128 + wr * 64 + m * 16 + fr;
            const int b = row >> 12, s = row & 4095;
            if (u.pn < 4) {
#pragma unroll
                for (int bj = 0; bj < 2; ++bj) { const int h = u.pn * 2 + bj, d = wc * 32 + fq * 8;
                    const f32x4 v0 = acc[ai][bj][m][0] * QSCALE, v1 = acc[ai][bj][m][1] * QSCALE;
                    u32x4 w; w.x = pk2(v0[0], v0[1]); w.y = pk2(v0[2], v0[3]); w.z = pk2(v1[0], v1[1]); w.w = pk2(v1[2], v1[3]);
                    *(u32x4*)(Q + ((size_t)(b * 8 + h) * SEQ + s) * 192 + d) = w; }
            } else {
                const int p0 = (u.pn - 4) * 128 + wc * 32 + fq * 8, h = p0 >> 5, i0 = p0 & 31;
                const f32x2* rp = rope + (size_t)(16 + s) * 32 + i0;
                float o1[8], o2[8];
#pragma unroll
                for (int n = 0; n < 2; ++n)
#pragma unroll
                    for (int j = 0; j < 4; ++j) { const f32x2 cs = rp[n * 4 + j]; const float x1 = acc[ai][0][m][n][j], x2 = acc[ai][1][m][n][j];
                        o1[n * 4 + j] = (x1 * cs.x - x2 * cs.y) * QSCALE; o2[n * 4 + j] = (x2 * cs.x + x1 * cs.y) * QSCALE; }
                bf16_t* qp = Q + ((size_t)(b * 8 + h) * SEQ + s) * 192 + 128 + i0;
                u32x4 w; w.x = pk2(o1[0], o1[1]); w.y = pk2(o1[2], o1[3]); w.z = pk2(o1[4], o1[5]); w.w = pk2(o1[6], o1[7]);
                *(u32x4*)qp = w;
                w.x = pk2(o2[0], o2[1]); w.y = pk2(o2[2], o2[3]); w.z = pk2(o2[4], o2[5]); w.w = pk2(o2[6], o2[7]);
                *(u32x4*)(qp + 32) = w;
            }
        }
    }
};
struct EpiKn {
    bf16_t* Kn;
    __device__ __forceinline__ void operator()(const f32x4 (&acc)[2][2][4][2], const Unit& u, int wr, int wc, int fr, int fq) const {
#pragma unroll
        EPI_LOOP_ROWS { const int row = u.pm * 256 + ai * 128 + wr * 64 + m * 16 + fr;
            if (row < MROWS) {
                int b, key; if (row < TR) { b = row >> 12; key = row & 4095; } else { b = (row - TR) >> 4; key = SEQ + ((row - TR) & 15); }
#pragma unroll
                for (int bj = 0; bj < 2; ++bj) { const int h = u.pn * 2 + bj, d = wc * 32 + fq * 8;
                    const f32x4 v0 = acc[ai][bj][m][0], v1 = acc[ai][bj][m][1];
                    u32x4 w; w.x = pk2(v0[0], v0[1]); w.y = pk2(v0[2], v0[3]); w.z = pk2(v1[0], v1[1]); w.w = pk2(v1[2], v1[3]);
                    *(u32x4*)(Kn + ((size_t)(b * 8 + h) * LK + key) * 128 + d) = w; }
            }
        }
    }
};
struct EpiVt {
    bf16_t* Vt;
    __device__ __forceinline__ void operator()(const f32x4 (&acc)[2][2][4][2], const Unit& u, int wr, int wc, int fr, int fq) const {
#pragma unroll
        EPI_LOOP_ROWS { const int f = u.pm * 256 + ai * 128 + wr * 64 + m * 16 + fr, h = f >> 7, d = f & 127;
#pragma unroll
            for (int bj = 0; bj < 2; ++bj) { const int row = u.pn * 256 + bj * 128 + wc * 32 + fq * 8;
                if (row < MROWS) {
                    int b, key; if (row < TR) { b = row >> 12; key = row & 4095; } else { b = (row - TR) >> 4; key = SEQ + ((row - TR) & 15); }
                    const f32x4 v0 = acc[ai][bj][m][0], v1 = acc[ai][bj][m][1];
                    u32x4 w; w.x = pk2(v0[0], v0[1]); w.y = pk2(v0[2], v0[3]); w.z = pk2(v1[0], v1[1]); w.w = pk2(v1[2], v1[3]);
                    bf16_t* vp = Vt + ((size_t)(b * 8 + h) * 128 + d) * LK + (key & ~15);
                    const int hi8 = (key >> 3) & 1;
                    *(u32x2*)(vp + (hi8 ? 4 : 0)) = (u32x2){w.x, w.y}; *(u32x2*)(vp + (hi8 ? 12 : 8)) = (u32x2){w.z, w.w}; }
            }
        }
    }
};
}

struct Args { const float* in[30]; float* out; unsigned char* wsp; };
enum { I_X = 0, I_META, I_F1G, I_F1U, I_F1D, I_LN1G, I_LN1B, I_WIN, I_QNG, I_WUQ, I_KVNG, I_WUKV, I_AOG, I_CW, I_CB, I_MWQ, I_MWK, I_MWV, I_WG, I_BG, I_GNG, I_SKIP,
       I_WOUT, I_LN2G, I_LN2B, I_F2G, I_F2U, I_F2D, I_LN3G, I_LN3B };

__device__ __forceinline__ int perm_qk(int n) { return n < 16 ? 8 * (n >> 2) + (n & 3) : 8 * ((n - 16) >> 2) + 4 + (n & 3); }
__device__ __forceinline__ void tr_item(const float* W, int N, bf16_t* WT, int ldt, int dst_row, int k0, int n0, LAS float* scr, int lane, float scale, bool perm = false) {
#pragma unroll 8
    for (int i = 0; i < 32; ++i) { const int kk = 2 * i + (lane >> 5); scr[kk * 33 + (lane & 31)] = __builtin_nontemporal_load(&W[(size_t)(k0 + kk) * N + n0 + (lane & 31)]); }
    LDS_WAIT(); asm volatile("" ::: "memory");
    const int c = lane & 7;
#pragma unroll
    for (int j = 0; j < 4; ++j) { const int n = (lane >> 3) + 8 * j; const LAS float* s = scr + (8 * c) * 33 + n;
        u32x4 o; o.x = pk2(s[0 * 33] * scale, s[1 * 33] * scale); o.y = pk2(s[2 * 33] * scale, s[3 * 33] * scale); o.z = pk2(s[4 * 33] * scale, s[5 * 33] * scale); o.w = pk2(s[6 * 33] * scale, s[7 * 33] * scale);
        *(u32x4*)(WT + (size_t)(dst_row + (perm ? perm_qk(n) : n)) * ldt + k0 + 8 * c) = o; }
    LDS_WAIT(); asm volatile("" ::: "memory");
}
__device__ __forceinline__ void ffn_weights(const float* Wg, const float* Wu, const float* Wd, unsigned char* ws, LAS float* scr, int gw, int NGW, int lane) {
    bf16_t* Wgu = (bf16_t*)(ws + WS_WGU); bf16_t* Wdt = (bf16_t*)(ws + WS_WD);
    for (int it = gw; it < 3 * 5632; it += NGW) {
        const int mat = it / 5632, r = it % 5632;
        if (mat < 2) { const int kb = r / 176, nb = r % 176, n0 = nb * 32; tr_item(mat ? Wu : Wg, FF, Wgu, DM, (n0 >> 7) * 256 + mat * 128 + (n0 & 127), kb * 64, n0, scr, lane, 1.f); }
        else { const int kb = r / 64, nb = r % 64; tr_item(Wd, DM, Wdt, FF, nb * 32, kb * 64, nb * 32, scr, lane, 1.f); }
    }
}
__device__ __forceinline__ void ln_row_b(const bf16_t* zr, const float* g, const float* bb, bf16_t* ob, float* of, int lane) {
    f32x4 v[8]; float s = 0.f;
#pragma unroll
    for (int j = 0; j < 4; ++j) { const u32x4 r = __builtin_nontemporal_load((const u32x4*)(zr + 8 * (lane + 64 * j)));
        v[2 * j] = (f32x4){bflo(r.x), bfhi(r.x), bflo(r.y), bfhi(r.y)}; v[2 * j + 1] = (f32x4){bflo(r.z), bfhi(r.z), bflo(r.w), bfhi(r.w)};
        s += (v[2 * j][0] + v[2 * j][1]) + (v[2 * j][2] + v[2 * j][3]) + (v[2 * j + 1][0] + v[2 * j + 1][1]) + (v[2 * j + 1][2] + v[2 * j + 1][3]); }
    const float mean = wave_sum(s) * (1.f / DM); float s2 = 0.f;
#pragma unroll
    for (int j = 0; j < 8; ++j) { v[j] = v[j] - mean; s2 += (v[j][0] * v[j][0] + v[j][1] * v[j][1]) + (v[j][2] * v[j][2] + v[j][3] * v[j][3]); }
    const float rstd = 1.f / sqrtf(wave_sum(s2) * (1.f / DM) + 1e-5f);
#pragma unroll
    for (int j = 0; j < 4; ++j) { const int c = 8 * (lane + 64 * j);
        const f32x4 o0 = v[2 * j] * rstd * *(const f32x4*)(g + c) + *(const f32x4*)(bb + c), o1 = v[2 * j + 1] * rstd * *(const f32x4*)(g + c + 4) + *(const f32x4*)(bb + c + 4);
        if (ob) { u32x4 w; w.x = pk2(o0[0], o0[1]); w.y = pk2(o0[2], o0[3]); w.z = pk2(o1[0], o1[1]); w.w = pk2(o1[2], o1[3]); *(u32x4*)(ob + c) = w; }
        else { __builtin_nontemporal_store(o0, (f32x4*)(of + c)); __builtin_nontemporal_store(o1, (f32x4*)(of + c + 4)); } }
}
__device__ __forceinline__ void ln_row(const float* zr, const float* g, const float* bb, bf16_t* ob, float* of, int lane) {
    f32x4 v[8]; float s = 0.f;
#pragma unroll
    for (int j = 0; j < 8; ++j) { v[j] = *(const f32x4*)(zr + 4 * (lane + 64 * j)); s += (v[j][0] + v[j][1]) + (v[j][2] + v[j][3]); }
    const float mean = wave_sum(s) * (1.f / DM); float s2 = 0.f;
#pragma unroll
    for (int j = 0; j < 8; ++j) { v[j] = v[j] - mean; s2 += (v[j][0] * v[j][0] + v[j][1] * v[j][1]) + (v[j][2] * v[j][2] + v[j][3] * v[j][3]); }
    const float rstd = 1.f / sqrtf(wave_sum(s2) * (1.f / DM) + 1e-5f);
#pragma unroll
    for (int j = 0; j < 8; ++j) { const int c = 4 * (lane + 64 * j); const f32x4 gg = *(const f32x4*)(g + c), b4 = *(const f32x4*)(bb + c);
        const f32x4 o = v[j] * rstd * gg + b4;
        if (ob) { u32x2 w; w.x = pk2(o[0], o[1]); w.y = pk2(o[2], o[3]); *(u32x2*)(ob + c) = w; } else *(f32x4*)(of + c) = o; }
}

__device__ __forceinline__ void attn_unit(LAS unsigned char* lds, const bf16_t* Q, const bf16_t* Kn, const bf16_t* Kr, const bf16_t* Vt, bf16_t* O, int b, int h, int qb, int wave_u) {
    int tid = wave_u * 64 + lane_id_v();
    const int wave = tid >> 6, lane = tid & 63, r = lane & 31, hh = lane >> 5;
    constexpr int ABUF = 44032;
    const bf16_t* qrow = Q + ((size_t)(b * 8 + h) * SEQ + qb * 256 + wave * 32 + r) * 192;
    bf16x8 qf[12];
#pragma unroll
    for (int ks = 0; ks < 12; ++ks) qf[ks] = *(const bf16x8*)(qrow + 16 * ks + 8 * hh);
    f32x16 oacc[4];
#pragma unroll
    for (int i = 0; i < 4; ++i)
#pragma unroll
        for (int j = 0; j < 16; ++j) oacc[i][j] = 0.f;
    float mrun = 0.f, lrun = 0.f;
    const bf16_t* Knb = Kn + (size_t)(b * 8 + h) * LK * 128; const bf16_t* Krb = Kr + (size_t)b * LK * 64; const bf16_t* Vtb = Vt + (size_t)(b * 8 + h) * 128 * LK;
    u32x4 pk[2], pr, pv[2];
    const int kc0 = tid, kc1 = tid + 512;
#define ATT_LOAD(kt) do { \
        pk[0] = *(const u32x4*)(Knb + (size_t)((kt) * 64 + (kc0 >> 4)) * 128 + (kc0 & 15) * 8); \
        pk[1] = *(const u32x4*)(Knb + (size_t)((kt) * 64 + (kc1 >> 4)) * 128 + (kc1 & 15) * 8); \
        pr = *(const u32x4*)(Krb + (size_t)((kt) * 64 + (tid >> 3)) * 64 + (tid & 7) * 8); \
        pv[0] = *(const u32x4*)(Vtb + (size_t)(kc0 >> 3) * LK + (kt) * 64 + (kc0 & 7) * 8); \
        pv[1] = *(const u32x4*)(Vtb + (size_t)(kc1 >> 3) * LK + (kt) * 64 + (kc1 & 7) * 8); } while (0)
#define ATT_STORE() do { \
        *(LAS u32x4*)(Ks + (kc0 >> 4) * 400 + (kc0 & 15) * 16) = pk[0]; \
        *(LAS u32x4*)(Ks + (kc1 >> 4) * 400 + (kc1 & 15) * 16) = pk[1]; \
        *(LAS u32x4*)(Ks + (tid >> 3) * 400 + 256 + (tid & 7) * 16) = pr; \
        *(LAS u32x4*)(Vs + (kc0 >> 3) * 144 + (kc0 & 7) * 16) = pv[0]; \
        *(LAS u32x4*)(Vs + (kc1 >> 3) * 144 + (kc1 & 7) * 16) = pv[1]; } while (0)
    ATT_LOAD(0);
    { LAS unsigned char* Ks = lds; LAS unsigned char* Vs = lds + 25600;
      ATT_STORE();
      ATT_LOAD(1); }
    for (int kt = 0; kt < 65; ++kt) {
        __syncthreads();
        LAS unsigned char* Ks = lds + (kt & 1) * ABUF; LAS unsigned char* Vs = Ks + 25600;
        f32x16 s0, s1;
        { const float negm = -mrun;
#pragma unroll
          for (int j = 0; j < 16; ++j) { s0[j] = negm; s1[j] = negm; } }
        {
            bf16x8 fa[3][4];
            const LAS unsigned char* k0p = Ks + r * 400 + hh * 16; const LAS unsigned char* k1p = k0p + 32 * 400;
#define ATT_RK(g, bf) do { fa[bf][0] = *(const LAS bf16x8*)(k0p + (2 * (g)) * 32); fa[bf][1] = *(const LAS bf16x8*)(k1p + (2 * (g)) * 32); \
                           fa[bf][2] = *(const LAS bf16x8*)(k0p + (2 * (g) + 1) * 32); fa[bf][3] = *(const LAS bf16x8*)(k1p + (2 * (g) + 1) * 32); } while (0)
            ATT_RK(0, 0);
            __builtin_amdgcn_sched_barrier(0);
            if (kt + 1 < 65) { LAS unsigned char* Ks = lds + ((kt + 1) & 1) * ABUF; LAS unsigned char* Vs = Ks + 25600; ATT_STORE(); }
            if (kt + 2 < 65) ATT_LOAD(kt + 2);
            ATT_RK(1, 1);
#pragma unroll
            for (int g = 0; g < 6; ++g) {
                if (g + 2 < 6) ATT_RK(g + 2, (g + 2) % 3);
                __builtin_amdgcn_sched_barrier(0);
                __builtin_amdgcn_s_setprio(1);
                s0 = __builtin_amdgcn_mfma_f32_32x32x16_bf16(fa[g % 3][0], qf[2 * g], s0, 0, 0, 0);
                s1 = __builtin_amdgcn_mfma_f32_32x32x16_bf16(fa[g % 3][1], qf[2 * g], s1, 0, 0, 0);
                s0 = __builtin_amdgcn_mfma_f32_32x32x16_bf16(fa[g % 3][2], qf[2 * g + 1], s0, 0, 0, 0);
                s1 = __builtin_amdgcn_mfma_f32_32x32x16_bf16(fa[g % 3][3], qf[2 * g + 1], s1, 0, 0, 0);
                __builtin_amdgcn_s_setprio(0);
                __builtin_amdgcn_sched_barrier(0);
            }
#undef ATT_RK
        }
        u32x4 fv[2][4];
        const LAS unsigned char* vbase = Vs + r * 144 + 16 * hh;
#define ATT_RV(kk, bf) do { _Pragma("unroll") for (int db = 0; db < 4; ++db) fv[bf][db] = *(const LAS u32x4*)(vbase + db * (32 * 144) + (kk) * 32); } while (0)
        ATT_RV(0, 0);
        if (kt == 64) {
#pragma unroll
            for (int j = 0; j < 16; ++j) { const int key = (j & 3) + 8 * (j >> 2) + 4 * hh;
                if (key >= 16) s0[j] = -1e30f; s1[j] = -1e30f; }
        }
        float mx = fmaxf(s0[0], s1[0]);
#pragma unroll
        for (int j = 1; j < 16; ++j) mx = fmaxf(mx, fmaxf(s0[j], s1[j]));
        mx = fmaxf(mx, shx(mx, lane, 32));
        if (__builtin_amdgcn_ballot_w64(fabsf(mx - (-28.0f)) > 36.0f) != 0ull) {
            const float shift = mx < -64.0f ? mx : fmaxf(mx, 0.f), alpha = __builtin_amdgcn_exp2f(-shift);
            mrun += shift; lrun *= alpha;
#pragma unroll
            for (int j = 0; j < 16; ++j) { s0[j] -= shift; s1[j] -= shift; }
#pragma unroll
            for (int i = 0; i < 4; ++i)
#pragma unroll
                for (int j = 0; j < 16; ++j) oacc[i][j] *= alpha;
        }
        { f32x2 ls2 = (f32x2){0.f, 0.f};
#pragma unroll
          for (int j = 0; j < 16; ++j) { s0[j] = __builtin_amdgcn_exp2f(s0[j]); s1[j] = __builtin_amdgcn_exp2f(s1[j]); ls2 += (f32x2){s0[j], s1[j]}; }
          lrun += ls2[0] + ls2[1]; }
        bf16x8 pf[4];
        { u32x4 t;
          t.x = cvtpk(s0[0], s0[1]); t.y = cvtpk(s0[2], s0[3]); t.z = cvtpk(s0[4], s0[5]); t.w = cvtpk(s0[6], s0[7]); pf[0] = __builtin_bit_cast(bf16x8, t);
          t.x = cvtpk(s0[8], s0[9]); t.y = cvtpk(s0[10], s0[11]); t.z = cvtpk(s0[12], s0[13]); t.w = cvtpk(s0[14], s0[15]); pf[1] = __builtin_bit_cast(bf16x8, t);
          t.x = cvtpk(s1[0], s1[1]); t.y = cvtpk(s1[2], s1[3]); t.z = cvtpk(s1[4], s1[5]); t.w = cvtpk(s1[6], s1[7]); pf[2] = __builtin_bit_cast(bf16x8, t);
          t.x = cvtpk(s1[8], s1[9]); t.y = cvtpk(s1[10], s1[11]); t.z = cvtpk(s1[12], s1[13]); t.w = cvtpk(s1[14], s1[15]); pf[3] = __builtin_bit_cast(bf16x8, t); }
        {
#pragma unroll
            for (int kk = 0; kk < 4; ++kk) {
                if (kk + 1 < 4) ATT_RV(kk + 1, (kk + 1) & 1);
                __builtin_amdgcn_sched_barrier(0);
#pragma unroll
                for (int db = 0; db < 4; ++db) oacc[db] = __builtin_amdgcn_mfma_f32_32x32x16_bf16(__builtin_bit_cast(bf16x8, fv[kk & 1][db]), pf[kk], oacc[db], 0, 0, 0);
                __builtin_amdgcn_sched_barrier(0);
            }
#undef ATT_RV
        }
    }
#undef ATT_LOAD
#undef ATT_STORE
    lrun += shx(lrun, lane, 32);
    const float inv = 1.f / lrun;
    bf16_t* orow = O + (size_t)(b * SEQ + qb * 256 + wave * 32 + r) * 1024 + h * 128;
#pragma unroll
    for (int db = 0; db < 4; ++db)
#pragma unroll
        for (int i4 = 0; i4 < 4; ++i4) { u32x2 w; w.x = pk2(oacc[db][4 * i4] * inv, oacc[db][4 * i4 + 1] * inv); w.y = pk2(oacc[db][4 * i4 + 2] * inv, oacc[db][4 * i4 + 3] * inv);
            *(u32x2*)(orow + 32 * db + 8 * i4 + 4 * hh) = w; }
}

__device__ __forceinline__ void ml_table_task(const float* gates, float* tab, int b, int h, int dir, int st, int lane) {
    const int l5 = lane & 31, tk = dir ? 31 - l5 : l5;
    const int rb = dir ? b * SEQ + (127 - st) * 32 : (st == 0 ? TR + b * 16 - 16 : b * SEQ + (st - 1) * 32);
    const bool valid = !(dir == 0 && st == 0 && tk < 16);
    float li = -1e30f, lf = 0.f;
    if (valid) { li = gates[(size_t)(rb + tk) * 16 + dir * 8 + h]; lf = gates[(size_t)(rb + tk) * 16 + dir * 8 + 4 + h]; }
    float bs = lf;
#pragma unroll
    for (int o = 1; o < 32; o <<= 1) { const float t = shl(bs, lane - o); if (l5 >= o) bs += t; }
    const float a = li - bs; float pm = a;
#pragma unroll
    for (int o = 1; o < 32; o <<= 1) { const float t = shl(pm, lane - o); if (l5 >= o) pm = fmaxf(pm, t); }
    float* T = tab + (size_t)st * 128;
    T[tk] = a; T[32 + tk] = pm; T[64 + tk] = bs;
    if (l5 == 31) { T[96] = bs; T[97] = pm; }
}
constexpr int MLB = 57344, ML_Q = 0, ML_K = 16384, ML_KT = 32768, ML_VT = 49152, ML_A = 114688, ML_SC = 117248;
__device__ __forceinline__ void dma16(const void* g, LAS unsigned char* l) { __builtin_amdgcn_global_load_lds((const unsigned*)g, (LAS unsigned*)l, 16, 0, 0); }
__device__ __forceinline__ void mlstm_unit(LAS unsigned char* lds, const bf16_t* mq, const bf16_t* mk, const bf16_t* mkT, const bf16_t* mvT, const float* gates, bf16_t* hout, float* tab, const void* zero16, int b, int h, int dir, int vh, int wave_u) {
    const int lane = lane_id_v(); const int tid = wave_u * 64 + lane;
    const int wave = wave_u;
    LAS float* SC = (LAS float*)(lds + ML_SC);
    LAS float* sa = SC; LAS float* spm = SC + 32; LAS float* sbb = SC + 64; LAS float* swt = SC + 96; LAS float* sei = SC + 128; LAS float* swc = SC + 160;
    LAS float* qnv = SC + 192; LAS float* rs = SC + 224; LAS float* nvec = SC + 288;
    const char* mqB = (const char*)(mq + (size_t)h * MR * 256); const char* mkB = (const char*)(mk + (size_t)h * MR * 256);
    const char* mkTB = (const char*)(mkT + (size_t)h * 256 * MR); const char* mvTB = (const char*)(mvT + ((size_t)h * 256 + vh * 128) * MR);
    const int nsteps = dir ? 128 : 129;
#define ML_RB(st) (dir ? b * SEQ + (127 - (st)) * 32 : ((st) == 0 ? TR + b * 16 - 16 : b * SEQ + ((st) - 1) * 32))
#define ML_META(st) (dir == 0 && (st) == 0)
    f32x4 Cacc[16];
#pragma unroll
    for (int i = 0; i < 16; ++i) Cacc[i] = (f32x4){0.f, 0.f, 0.f, 0.f};
    if (tid < 256) nvec[tid] = 0.f;
    __syncthreads();
#define ML_DMA(st, bf) do { const int rb_ = ML_RB(st); const bool meta_ = ML_META(st); LAS unsigned char* base_ = lds + (bf) * MLB; \
        _Pragma("unroll") for (int i = 0; i < 2; ++i) { const int q_ = wave * 2 + i, row = 2 * q_ + (lane_o >> 5), cs = (lane_o & 31) ^ (row & 15); \
            const bool ok = !meta_ || row >= 16; const size_t off = (size_t)(rb_ + row) * 512 + cs * 16; \
            dma16(ok ? (const void*)(mqB + off) : zero16, base_ + ML_Q + q_ * 1024); dma16(ok ? (const void*)(mkB + off) : zero16, base_ + ML_K + q_ * 1024); } \
        _Pragma("unroll") for (int i = 0; i < 2; ++i) { const int q_ = wave * 2 + i, d = 16 * q_ + (lane_o >> 2), cs = (lane_o & 3) ^ ((d >> 2) & 3); \
            const bool ok = !meta_ || cs >= 2; dma16(ok ? (const void*)(mkTB + ((size_t)d * MR + rb_ + cs * 8) * 2) : zero16, base_ + ML_KT + q_ * 1024); } \
        { const int q_ = wave, v = 16 * q_ + (lane_o >> 2), cs = (lane_o & 3) ^ ((v >> 2) & 3); \
            const bool ok = !meta_ || cs >= 2; dma16(ok ? (const void*)(mvTB + ((size_t)v * MR + rb_ + cs * 8) * 2) : zero16, base_ + ML_VT + q_ * 1024); } } while (0)
    float mstate = 0.f;
    float bL = tab[96], amax = tab[97];
    if (tid < 32) { sa[tid] = tab[tid]; spm[tid] = tab[32 + tid]; sbb[tid] = tab[64 + tid]; }
    { const int lane_o = lane; ML_DMA(0, 0); }
    asm volatile("s_waitcnt vmcnt(0)" ::: "memory");
    __syncthreads();
    for (int st = 0; st < nsteps; ++st) {
        const int lane_o = lane;
        const int frl = lane_o & 15, fql = lane_o >> 4, tidl = wave * 64 + lane_o;
        const int cur = st & 1; LAS unsigned char* B_ = lds + cur * MLB;
        float na = 0.f, npm = 0.f, nbb = 0.f, nbL = 0.f, namax = 0.f;
        if (st + 1 < nsteps) { const float* Tn = tab + (size_t)(st + 1) * 128; nbL = Tn[96]; namax = Tn[97]; if (tidl < 32) { na = Tn[tidl]; npm = Tn[32 + tidl]; nbb = Tn[64 + tidl]; } }
        asm volatile("" ::: "memory");
        if (st + 1 < nsteps) ML_DMA(st + 1, cur ^ 1);
        const float mrel = fmaxf(mstate, amax), decay = __expf(mstate - mrel);
        if (tidl < 32) { const float Mt = fmaxf(mstate, spm[tidl]); swt[tidl] = __expf(mstate - Mt); sei[tidl] = __expf(-(sbb[tidl] + Mt)); swc[tidl] = __expf(sa[tidl] - mrel); }
        if (wave < 4) { const int si = wave >> 1, tj = wave & 1;
            const bool skip = dir ? (si < tj) : (si > tj);
            f32x4 acc = (f32x4){0.f, 0.f, 0.f, 0.f};
            if (!skip) {
#pragma unroll
                for (int kk = 0; kk < 8; ++kk) { const int cs = ((4 * kk + fql) ^ frl) * 16;
                    const bf16x8 a = *(const LAS bf16x8*)(B_ + ML_K + (16 * si + frl) * 512 + cs);
                    const bf16x8 bq = *(const LAS bf16x8*)(B_ + ML_Q + (16 * tj + frl) * 512 + cs);
                    acc = __builtin_amdgcn_mfma_f32_16x16x32_bf16(a, bq, acc, 0, 0, 0);
                }
            }
            const int t = 16 * tj + frl; const float Mt = fmaxf(mstate, spm[t]); float ps = 0.f; float o[4];
            const f32x4 sa4 = *(const LAS f32x4*)(sa + 16 * si + 4 * fql);
#pragma unroll
            for (int j = 0; j < 4; ++j) { const int s_ = 16 * si + 4 * fql + j; const bool ok = !skip && (dir ? (s_ >= t) : (s_ <= t));
                o[j] = ok ? __expf(sa4[j] - Mt) * acc[j] : 0.f; ps += o[j]; }
            u32x2 w; w.x = cvtpk(o[0], o[1]); w.y = cvtpk(o[2], o[3]);
            *(LAS u32x2*)(lds + ML_A + t * 80 + (16 * si + 4 * fql) * 2) = w;
            ps += shx(ps, lane_o, 16); ps += shx(ps, lane_o, 32);
            if (fql == 0) rs[si * 32 + t] = ps; }
        if (wave >= 4) { const int t2 = (tidl - 256) >> 3, part = tidl & 7; float dsum = 0.f;
#pragma unroll
          for (int i = 0; i < 4; ++i) { const u32x4 qv = *(const LAS u32x4*)(B_ + ML_Q + t2 * 512 + (((4 * part + i) ^ (t2 & 15)) * 16)); const LAS float* nn = nvec + part * 32 + i * 8;
              dsum += bflo(qv.x) * nn[0] + bfhi(qv.x) * nn[1] + bflo(qv.y) * nn[2] + bfhi(qv.y) * nn[3] + bflo(qv.z) * nn[4] + bfhi(qv.z) * nn[5] + bflo(qv.w) * nn[6] + bfhi(qv.w) * nn[7]; }
          dsum += shx(dsum, lane_o, 1); dsum += shx(dsum, lane_o, 2); dsum += shx(dsum, lane_o, 4);
          if (part == 0) qnv[t2] = dsum; }
        f32x4 num[2];
#pragma unroll
        for (int ti = 0; ti < 2; ++ti) num[ti] = (f32x4){0.f, 0.f, 0.f, 0.f};
#pragma unroll
        for (int i = 0; i < 8; ++i) {
            u32x4 cb; cb.x = cvtpk(Cacc[2 * i][0], Cacc[2 * i][1]); cb.y = cvtpk(Cacc[2 * i][2], Cacc[2 * i][3]); cb.z = cvtpk(Cacc[2 * i + 1][0], Cacc[2 * i + 1][1]); cb.w = cvtpk(Cacc[2 * i + 1][2], Cacc[2 * i + 1][3]);
            const bf16x8 bfr = __builtin_bit_cast(bf16x8, cb);
            const int c0s = ((4 * i + fql) ^ frl) * 16;
#pragma unroll
            for (int ti = 0; ti < 2; ++ti) {
                const bf16x8 qa = *(const LAS bf16x8*)(B_ + ML_Q + (16 * ti + frl) * 512 + c0s);
                num[ti] = __builtin_amdgcn_mfma_f32_16x16x32_bf16(qa, bfr, num[ti], 0, 0, 0);
            }
        }
        asm volatile("s_waitcnt lgkmcnt(0)" ::: "memory");
        __builtin_amdgcn_s_barrier();
        asm volatile("" ::: "memory");
        bf16x8 vfr, vfw;
        { const int v = 16 * wave + frl;
            const u32x4 raw = *(const LAS u32x4*)(B_ + ML_VT + v * 64 + ((fql ^ ((v >> 2) & 3)) * 16));
            vfr = __builtin_bit_cast(bf16x8, raw);
            const LAS float* w = swc + 8 * fql; u32x4 sc;
            sc.x = cvtpk(bflo(raw.x) * w[0], bfhi(raw.x) * w[1]); sc.y = cvtpk(bflo(raw.y) * w[2], bfhi(raw.y) * w[3]); sc.z = cvtpk(bflo(raw.z) * w[4], bfhi(raw.z) * w[5]); sc.w = cvtpk(bflo(raw.w) * w[6], bfhi(raw.w) * w[7]);
            vfw = __builtin_bit_cast(bf16x8, sc); }
#pragma unroll
        for (int ti = 0; ti < 2; ++ti) {
            num[ti] = num[ti] * *(const LAS f32x4*)(swt + 16 * ti + 4 * fql);
            const bf16x8 a = *(const LAS bf16x8*)(lds + ML_A + (16 * ti + frl) * 80 + fql * 16);
            num[ti] = __builtin_amdgcn_mfma_f32_16x16x32_bf16(a, vfr, num[ti], 0, 0, 0);
        }
        if (!ML_META(st)) { bf16_t* hb_ = hout + (size_t)ML_RB(st) * 1024 + h * 256 + vh * 128 + 16 * wave;
#pragma unroll
            for (int ti = 0; ti < 2; ++ti) { const int t0 = 16 * ti + 4 * fql;
                const f32x4 den = *(const LAS f32x4*)(rs + t0) + *(const LAS f32x4*)(rs + 32 + t0) + *(const LAS f32x4*)(swt + t0) * *(const LAS f32x4*)(qnv + t0);
                const f32x4 fl = *(const LAS f32x4*)(sei + t0);
#pragma unroll
                for (int j = 0; j < 4; ++j) { const float hv = num[ti][j] * __builtin_amdgcn_rcpf(fmaxf(fabsf(den[j]), fl[j]));
                    hb_[(unsigned)((t0 + j) * 1024 + frl)] = (bf16_t)(cvtpk(hv, 0.f) & 0xffffu); } }
        }
#pragma unroll
        for (int dt = 0; dt < 16; ++dt) { const int d = 16 * dt + frl;
            Cacc[dt] = Cacc[dt] * decay;
            const bf16x8 a = *(const LAS bf16x8*)(B_ + ML_KT + d * 64 + ((fql ^ ((d >> 2) & 3)) * 16));
            Cacc[dt] = __builtin_amdgcn_mfma_f32_16x16x32_bf16(a, vfw, Cacc[dt], 0, 0, 0);
        }
        if (tidl < 256) { float sum = 0.f;
#pragma unroll
            for (int i = 0; i < 4; ++i) { const u32x4 kv = *(const LAS u32x4*)(B_ + ML_KT + tidl * 64 + ((i ^ ((tidl >> 2) & 3)) * 16)); const LAS float* w = swc + 8 * i;
                sum += bflo(kv.x) * w[0] + bfhi(kv.x) * w[1] + bflo(kv.y) * w[2] + bfhi(kv.y) * w[3] + bflo(kv.z) * w[4] + bfhi(kv.z) * w[5] + bflo(kv.w) * w[6] + bfhi(kv.w) * w[7]; }
            const int pd = (tidl & ~31) | perm_qk(tidl & 31);
            nvec[pd] = decay * nvec[pd] + sum; }
        asm volatile("s_waitcnt vmcnt(0)" ::: "memory");
        mstate = bL + mrel; bL = nbL; amax = namax;
        if (st + 1 < nsteps && tidl < 32) { sa[tidl] = na; spm[tidl] = npm; sbb[tidl] = nbb; }
        __syncthreads();
    }
#undef ML_DMA
#undef ML_RB
#undef ML_META
}

__device__ __forceinline__ f32x4 skinny16(const bf16_t* A, int lda, const bf16_t* Bt, int ldb, int K, int fr, int fq) {
    f32x4 acc0 = (f32x4){0.f, 0.f, 0.f, 0.f}, acc1 = (f32x4){0.f, 0.f, 0.f, 0.f};
    const bf16_t* ap = A + (size_t)fr * lda + 8 * fq; const bf16_t* bp = Bt + (size_t)fr * ldb + 8 * fq;
#pragma unroll 4
    for (int k = 0; k < K; k += 64) {
        const bf16x8 a0 = *(const bf16x8*)(ap + k), b0 = *(const bf16x8*)(bp + k), a1 = *(const bf16x8*)(ap + k + 32), b1 = *(const bf16x8*)(bp + k + 32);
        acc0 = __builtin_amdgcn_mfma_f32_16x16x32_bf16(a0, b0, acc0, 0, 0, 0);
        acc1 = __builtin_amdgcn_mfma_f32_16x16x32_bf16(a1, b1, acc1, 0, 0, 0);
    }
    return acc0 + acc1;
}

#define XB_TMO      128
#define XB_XCNT(j)  (256  + 64 * (j))
#define XB_XSUB(j)  (1280 + 64 * (j))
#define XB_XGEN(j)  (2304 + 64 * (j))
#define XB_TOP      3328
#define XB_TOPGEN   3392
#define XCD_BAR_WORDS 3456
#define XB_SPIN_CAP (1u << 18)

__device__ __forceinline__ unsigned xb_ld(unsigned* p)              { return __hip_atomic_load(p, __ATOMIC_RELAXED, __HIP_MEMORY_SCOPE_AGENT); }
__device__ __forceinline__ unsigned xb_add(unsigned* p, unsigned v) { return __hip_atomic_fetch_add(p, v, __ATOMIC_RELAXED, __HIP_MEMORY_SCOPE_AGENT); }
__device__ __forceinline__ unsigned xb_xcc_id() { return (unsigned)__builtin_amdgcn_s_getreg((3 << 11) | 20) & 0xFu; }
#define XB_SPIN(cond, bar) do { unsigned _sp = 0; while (cond) { __builtin_amdgcn_s_sleep(1); \
    if ((++_sp & 255u) == 0u) { if (xb_ld(&(bar)[XB_TMO])) break; if (_sp > XB_SPIN_CAP) { atomicAdd(&(bar)[XB_TMO], 1u); break; } } } } while (0)

struct XcdBarrier {
    unsigned* bar; unsigned x;
    volatile LAS unsigned* st;
};

__device__ __forceinline__ XcdBarrier xcd_barrier_post(unsigned* bar, volatile LAS unsigned* st) {
    XcdBarrier b; b.bar = bar; b.x = xb_xcc_id(); b.st = st;
    if (threadIdx.x == 0) (void)xb_add(&bar[XB_XCNT(b.x)], 1u);
    return b;
}
__device__ __forceinline__ void xcd_barrier_complete(unsigned* bar, unsigned x, unsigned& nloc, unsigned& nx) {
    const unsigned G = gridDim.x * gridDim.y * gridDim.z;
    unsigned sum, cnt, mine, sp = 0u;
    for (;;) {
        sum = 0u; cnt = 0u; mine = 0u;
#pragma unroll
        for (unsigned j = 0; j < 16; ++j) { const unsigned c = xb_ld(&bar[XB_XCNT(j)]); sum += c; cnt += (c > 0u) ? 1u : 0u; mine = (j == x) ? c : mine; }
        if (sum == G) break;
        __builtin_amdgcn_s_sleep(1);
        if ((++sp & 255u) == 0u) { if (xb_ld(&bar[XB_TMO])) break; if (sp > XB_SPIN_CAP) { atomicAdd(&bar[XB_TMO], 1u); break; } }
    }
    nloc = mine > 0u ? mine : 1u; nx = cnt > 0u ? cnt : 1u;
}

__device__ __forceinline__ void xcd_barrier(const XcdBarrier& b) {
    asm volatile("s_waitcnt vmcnt(0)" ::: "memory");
    __syncthreads();
    if (threadIdx.x == 0) {
        unsigned* bar = b.bar;
        __builtin_amdgcn_s_waitcnt(0);
        unsigned nloc = b.st[0], nx = b.st[1];
        if (nloc == 0u) { xcd_barrier_complete(bar, b.x, nloc, nx); b.st[0] = nloc; b.st[1] = nx; }
        const unsigned old = xb_add(&bar[XB_XSUB(b.x)], 1u);
        const unsigned gen = old / nloc;
        if (old + 1u == (gen + 1u) * nloc) {
            __builtin_amdgcn_fence(__ATOMIC_RELEASE, "agent");
            asm volatile("s_waitcnt vmcnt(0)" ::: "memory");
            const unsigned og = xb_add(&bar[XB_TOP], 1u);
            const unsigned tg = og / nx;
            if (og + 1u == (tg + 1u) * nx) xb_add(&bar[XB_TOPGEN], 1u);
            else XB_SPIN(xb_ld(&bar[XB_TOPGEN]) == tg, bar);
            __builtin_amdgcn_fence(__ATOMIC_ACQUIRE, "agent");
            xb_add(&bar[XB_XGEN(b.x)], 1u);
            asm volatile("s_waitcnt vmcnt(0)" ::: "memory");
        } else {
            XB_SPIN(xb_ld(&bar[XB_XGEN(b.x)]) == gen, bar);
            __builtin_amdgcn_fence(__ATOMIC_ACQUIRE, "agent");
            asm volatile("s_waitcnt vmcnt(0)" ::: "memory");
        }
    }
    __syncthreads();
}

__global__ void __launch_bounds__(NTHR, 2) fwd_mega(Args args) {
    extern __shared__ __attribute__((aligned(16))) unsigned char lds_raw[];
    LAS unsigned char* lds = (LAS unsigned char*)lds_raw;
    cg::grid_group grid = cg::this_grid();
    const int G = gridDim.x;
    if (threadIdx.x < 2) ((volatile LAS unsigned*)(lds + 140016))[threadIdx.x] = 0u;
    __syncthreads();
    XcdBarrier xbar = xcd_barrier_post((unsigned*)(args.wsp + WS_BAR), (volatile LAS unsigned*)(lds + 140016));
    if (gridDim.x == 0x7fffffffu) grid.sync();
    const int wave_u = __builtin_amdgcn_readfirstlane((int)(threadIdx.x >> 6));
#define PHASE_VARS int tid = wave_u * 64 + lane_id_v(); const int lane = tid & 63, wave = tid >> 6, gw = blockIdx.x * 8 + wave, NGW = G * 8; LAS float* scr = (LAS float*)(lds + wave * 16384); (void)lane; (void)gw; (void)NGW; (void)scr;
#define ws (args.wsp)
#define ctl ((unsigned*)(args.wsp + WS_CTL))
#define rope ((f32x2*)(args.wsp + WS_ROPE))
#define zmeta ((float*)(args.wsp + WS_ZMETA))
#define h0 ((bf16_t*)(args.wsp + WS_H0))
#define h1 ((bf16_t*)(args.wsp + WS_H1))
#define h2 ((bf16_t*)(args.wsp + WS_H2))
#define Gb ((bf16_t*)(args.wsp + WS_G))
#define ub ((bf16_t*)(args.wsp + WS_U))
#define qn ((bf16_t*)(args.wsp + WS_QN))
#define kvn ((bf16_t*)(args.wsp + WS_KVN))
#define xc ((bf16_t*)(args.wsp + WS_XC))
#define gates ((float*)(args.wsp + WS_GATES))
#define Kn ((bf16_t*)(args.wsp + WS_KN))
#define Vt ((bf16_t*)(args.wsp + WS_VT))
#define Kr ((bf16_t*)(args.wsp + WS_KROPE))
#define oatt ((bf16_t*)(args.wsp + WS_OATT))
#define mkT ((bf16_t*)(args.wsp + WS_MKT))
#define mq ((bf16_t*)(args.wsp + WS_MQ))
#define mk ((bf16_t*)(args.wsp + WS_MK))
#define mvT ((bf16_t*)(args.wsp + WS_MVT))
#define ycat ((bf16_t*)(args.wsp + WS_YCAT))
#define Qb ((bf16_t*)((unsigned char*)args.out + DO_Q))
#define hf ((bf16_t*)((unsigned char*)args.out + DO_HF))
#define hb ((bf16_t*)((unsigned char*)args.out + DO_HB))

    {
        PHASE_VARS
        ffn_weights(args.in[I_F1G], args.in[I_F1U], args.in[I_F1D], ws, scr, gw, NGW, lane);
        constexpr int N_WIN = 32 * 90, N_WUQ = 8 * 48, N_WKV = 4 * 64, N_M = 3 * 4 * 4 * 8, N_WOUT = 32 * 64;
        for (int it = gw; it < N_WIN + N_WUQ + N_WKV + N_M + N_WOUT; it += NGW) {
            int r = it;
            if (r < N_WIN) { const int kb = r / 90, nb = r % 90; tr_item(args.in[I_WIN], 2880, (bf16_t*)(ws + WS_WIN), DM, nb * 32, kb * 64, nb * 32, scr, lane, 1.f); continue; } r -= N_WIN;
            if (r < N_WUQ) { const int kb = r / 48, nb = r % 48, n0 = nb * 32, hq = n0 / 192, d0 = n0 % 192; int dst;
                if (d0 < 128) dst = hq * 128 + d0; else { const int p = hq * 32; dst = 1024 + (p >> 7) * 256 + (d0 >= 160 ? 128 : 0) + (p & 127); }
                tr_item(args.in[I_WUQ], 1536, (bf16_t*)(ws + WS_WUQ), 512, dst, kb * 64, n0, scr, lane, 1.f); continue; } r -= N_WUQ;
            if (r < N_WKV) { const int kb = r / 64, nb = r % 64, n0 = nb * 32, hk = n0 >> 8, c0 = n0 & 255;
                if (c0 < 128) tr_item(args.in[I_WUKV], 2048, (bf16_t*)(ws + WS_WK), 256, hk * 128 + c0, kb * 64, n0, scr, lane, 1.f);
                else tr_item(args.in[I_WUKV], 2048, (bf16_t*)(ws + WS_WV), 256, hk * 128 + c0 - 128, kb * 64, n0, scr, lane, 1.f);
                continue; } r -= N_WKV;
            if (r < N_M) { const int mat = r / 128, hm = (r % 128) / 32, q = r % 32, kb = q / 8, nb = q % 8;
                const float* src = args.in[I_MWQ + mat] + (size_t)hm * 65536;
                bf16_t* dst = (bf16_t*)(ws + (mat == 0 ? WS_WMQ : mat == 1 ? WS_WMK : WS_WMV)) + (size_t)hm * 65536;
                tr_item(src, 256, dst, 256, nb * 32, kb * 64, nb * 32, scr, lane, mat == 1 ? 0.0625f : 1.f, mat < 2);
                if (mat == 1) tr_item(src, 256, (bf16_t*)(ws + WS_WMKN) + (size_t)hm * 65536, 256, nb * 32, kb * 64, nb * 32, scr, lane, 0.0625f);
                continue; } r -= N_M;
            { const int kb = r / 64, nb = r % 64; tr_item(args.in[I_WOUT], DM, (bf16_t*)(ws + WS_WOUT), DM, nb * 32, kb * 64, nb * 32, scr, lane, 1.f); }
        }
        for (int row = gw; row < MR; row += NGW) {
            const float* src = row < TR ? args.in[I_X] + (size_t)row * DM : (row < MROWS ? args.in[I_META] + (size_t)((row - TR) & 15) * DM : nullptr);
#pragma unroll
            for (int j = 0; j < 4; ++j) { const int c = 8 * (lane + 64 * j); u32x4 w = (u32x4){0, 0, 0, 0};
                if (src) { const f32x4 a = __builtin_nontemporal_load((const f32x4*)(src + c)), bq = __builtin_nontemporal_load((const f32x4*)(src + c + 4)); w.x = pk2(a[0], a[1]); w.y = pk2(a[2], a[3]); w.z = pk2(bq[0], bq[1]); w.w = pk2(bq[2], bq[3]); }
                *(u32x4*)(h0 + (size_t)row * DM + c) = w; }
        }
        for (int i = blockIdx.x * NTHR + tid; i < 16 * 2048; i += G * NTHR) { const int gi = i >> 11, k = i & 2047; ((bf16_t*)(ws + WS_WGT))[i] = (bf16_t)f2bf(args.in[I_WG][(size_t)k * 16 + gi]); }
        for (int i = blockIdx.x * NTHR + tid; i < LTOT * 32; i += G * NTHR) { const int pos = i >> 5, k = i & 31;
            const float inv = powf(10000.f, -(float)(2 * k) / 64.f), ang = (float)pos * inv; rope[i] = (f32x2){cosf(ang), sinf(ang)}; }
    }
    xcd_barrier(xbar);
    { pg8::Gemm g{DM, DM, DM}; pg8::Sched S; S.init(TR / 256, 44, 1, G, blockIdx.x, h0, ws + WS_WGU, 0, 0, 1, DM, DM);
      pg8::EpiSwiGLU E{Gb}; pg8::gemm_phase<GEMM_SP2, GEMM_ALIGN>(lds, g, S, E, wave_u); }
    { PHASE_VARS const int fr = lane & 15, fq = lane >> 4; LAS float* red = (LAS float*)lds;
      for (int bu = blockIdx.x; bu < FF / 16; bu += G) { const int f0 = bu * 16, r0 = (f0 >> 7) * 256 + (f0 & 127), k0 = wave * (DM / 8);
          const f32x4 ag = skinny16(h0 + (size_t)TR * DM + k0, DM, (const bf16_t*)(ws + WS_WGU) + (size_t)r0 * DM + k0, DM, DM / 8, fr, fq);
          const f32x4 au = skinny16(h0 + (size_t)TR * DM + k0, DM, (const bf16_t*)(ws + WS_WGU) + (size_t)(r0 + 128) * DM + k0, DM, DM / 8, fr, fq);
#pragma unroll
          for (int j = 0; j < 4; ++j) { red[(wave * 16 + 4 * fq + j) * 16 + fr] = ag[j]; red[2048 + (wave * 16 + 4 * fq + j) * 16 + fr] = au[j]; }
          __syncthreads();
          if (tid < 256) { float g = 0.f, u = 0.f;
#pragma unroll
              for (int w = 0; w < 8; ++w) { g += red[w * 256 + tid]; u += red[2048 + w * 256 + tid]; }
              Gb[(size_t)(TR + (tid >> 4)) * FF + f0 + (tid & 15)] = (bf16_t)f2bf(siluf(g) * u); }
          __syncthreads(); } }
    xcd_barrier(xbar);
    { pg8::Gemm g{FF, FF, FF}; pg8::Sched S; S.init(TR / 256, 8, 1, G, blockIdx.x, Gb, ws + WS_WD, 0, 0, 1, FF, FF);
      pg8::EpiResid E{h0, (bf16_t*)(ws + WS_RM), 0.5f}; pg8::gemm_phase<GEMM_SP2, GEMM_ALIGN>(lds, g, S, E, wave_u); }
    { PHASE_VARS const int fr = lane & 15, fq = lane >> 4; LAS float* red = (LAS float*)lds;
      for (int bu = blockIdx.x; bu < DM / 16; bu += G) { const int c0 = bu * 16, k0 = wave * (FF / 8);
          const f32x4 a = skinny16(Gb + (size_t)TR * FF + k0, FF, (const bf16_t*)(ws + WS_WD) + (size_t)c0 * FF + k0, FF, FF / 8, fr, fq);
#pragma unroll
          for (int j = 0; j < 4; ++j) red[(wave * 16 + 4 * fq + j) * 16 + fr] = a[j];
          __syncthreads();
          if (tid < 256) { float v = 0.f;
#pragma unroll
              for (int w = 0; w < 8; ++w) v += red[w * 256 + tid];
              const int m = tid >> 4, c = c0 + (tid & 15); v = ALPHA * bf1(h0[(size_t)(TR + m) * DM + c]) + 0.5f * v;
#pragma unroll
              for (int bb = 0; bb < 4; ++bb) zmeta[(size_t)(bb * 16 + m) * DM + c] = v; }
          __syncthreads(); } }
    xcd_barrier(xbar);
    { PHASE_VARS
    for (int row = gw; row < MROWS; row += NGW) {
        if (row < TR) ln_row_b((const bf16_t*)(ws + WS_RM) + (size_t)row * DM, args.in[I_LN1G], args.in[I_LN1B], h1 + (size_t)row * DM, nullptr, lane);
        else ln_row(zmeta + (size_t)(row - TR) * DM, args.in[I_LN1G], args.in[I_LN1B], h1 + (size_t)row * DM, nullptr, lane); } }
    xcd_barrier(xbar);
    { pg8::Gemm g{DM, DM, DM}; pg8::Sched S; S.init(TR / 256, 12, 1, G, blockIdx.x, h1, ws + WS_WIN, 0, 0, 1, DM, DM);
      pg8::EpiBf16 E{ub, UW, 0, 1 << 30, 1.f}; pg8::gemm_phase<GEMM_SP2, GEMM_ALIGN>(lds, g, S, E, wave_u); }
    { PHASE_VARS const int fr = lane & 15, fq = lane >> 4; LAS float* red = (LAS float*)lds;
      for (int bu = blockIdx.x; bu < 2880 / 16; bu += G) { const int c0 = bu * 16, k0 = wave * (DM / 8);
          const f32x4 a = skinny16(h1 + (size_t)TR * DM + k0, DM, (const bf16_t*)(ws + WS_WIN) + (size_t)c0 * DM + k0, DM, DM / 8, fr, fq);
#pragma unroll
          for (int j = 0; j < 4; ++j) red[(wave * 16 + 4 * fq + j) * 16 + fr] = a[j];
          __syncthreads();
          if (tid < 256) { float v = 0.f;
#pragma unroll
              for (int w = 0; w < 8; ++w) v += red[w * 256 + tid];
              const int m = tid >> 4, c = c0 + (tid & 15); const bf16_t o = (bf16_t)f2bf(v);
#pragma unroll
              for (int bb = 0; bb < 4; ++bb) ub[(size_t)(TR + bb * 16 + m) * UW + c] = o; }
          __syncthreads(); } }
    xcd_barrier(xbar);
    {
        PHASE_VARS
        const float* cw = args.in[I_CW]; const float* cb = args.in[I_CB];
        for (int row = gw; row < MROWS; row += NGW) {
            int b, pos, key; if (row < TR) { b = row >> 12; key = row & 4095; pos = 16 + key; } else { b = (row - TR) >> 4; pos = (row - TR) & 15; key = SEQ + pos; }
            const bf16_t* ur = ub + (size_t)row * UW;
            { const u32x4 v = *(const u32x4*)(ur + 8 * lane); float f[8] = {bflo(v.x), bfhi(v.x), bflo(v.y), bfhi(v.y), bflo(v.z), bfhi(v.z), bflo(v.w), bfhi(v.w)};
              float ss = 0.f;
#pragma unroll
              for (int i = 0; i < 8; ++i) ss += f[i] * f[i];
              const float rms = 1.f / sqrtf(wave_sum(ss) * (1.f / 512.f) + 1e-6f); const float* gq = args.in[I_QNG] + 8 * lane;
              u32x4 w; w.x = pk2(f[0] * rms * gq[0], f[1] * rms * gq[1]); w.y = pk2(f[2] * rms * gq[2], f[3] * rms * gq[3]); w.z = pk2(f[4] * rms * gq[4], f[5] * rms * gq[5]); w.w = pk2(f[6] * rms * gq[6], f[7] * rms * gq[7]);
              *(u32x4*)(qn + (size_t)row * 512 + 8 * lane) = w; }
            { const u32x2 v = *(const u32x2*)(ur + O2 + 4 * lane); float f[4] = {bflo(v.x), bfhi(v.x), bflo(v.y), bfhi(v.y)};
              const float ss = f[0] * f[0] + f[1] * f[1] + f[2] * f[2] + f[3] * f[3];
              const float rms = 1.f / sqrtf(wave_sum(ss) * (1.f / 256.f) + 1e-6f); const float* gk = args.in[I_KVNG] + 4 * lane;
              u32x2 w; w.x = pk2(f[0] * rms * gk[0], f[1] * rms * gk[1]); w.y = pk2(f[2] * rms * gk[2], f[3] * rms * gk[3]);
              *(u32x2*)(kvn + (size_t)row * 256 + 4 * lane) = w; }
            if (lane < 32) { const float x1 = bf1(ur[O3 + lane]), x2 = bf1(ur[O3 + 32 + lane]); const f32x2 cs = rope[pos * 32 + lane];
              bf16_t* kp = Kr + ((size_t)b * LK + key) * 64; kp[lane] = (bf16_t)f2bf(x1 * cs.x - x2 * cs.y); kp[32 + lane] = (bf16_t)f2bf(x2 * cs.x + x1 * cs.y); }
            { float acc[16];
#pragma unroll
              for (int i = 0; i < 16; ++i) acc[i] = cb[16 * lane + i];
#pragma unroll
              for (int t = 0; t < 5; ++t) { const int q = pos - 2 + t;
                  if (q >= 0 && q < LTOT) { const int nr = q < 16 ? TR + b * 16 + q : b * SEQ + q - 16; const bf16_t* xr = ub + (size_t)nr * UW + O4 + 16 * lane;
                      const u32x4 v0 = *(const u32x4*)xr, v1 = *(const u32x4*)(xr + 8); const float* wt = cw + t * 1024 + 16 * lane;
                      acc[0] += wt[0] * bflo(v0.x); acc[1] += wt[1] * bfhi(v0.x); acc[2] += wt[2] * bflo(v0.y); acc[3] += wt[3] * bfhi(v0.y);
                      acc[4] += wt[4] * bflo(v0.z); acc[5] += wt[5] * bfhi(v0.z); acc[6] += wt[6] * bflo(v0.w); acc[7] += wt[7] * bfhi(v0.w);
                      acc[8] += wt[8] * bflo(v1.x); acc[9] += wt[9] * bfhi(v1.x); acc[10] += wt[10] * bflo(v1.y); acc[11] += wt[11] * bfhi(v1.y);
                      acc[12] += wt[12] * bflo(v1.z); acc[13] += wt[13] * bfhi(v1.z); acc[14] += wt[14] * bflo(v1.w); acc[15] += wt[15] * bfhi(v1.w); } }
              u32x4 w0, w1;
              w0.x = pk2(siluf(acc[0]), siluf(acc[1])); w0.y = pk2(siluf(acc[2]), siluf(acc[3])); w0.z = pk2(siluf(acc[4]), siluf(acc[5])); w0.w = pk2(siluf(acc[6]), siluf(acc[7]));
              w1.x = pk2(siluf(acc[8]), siluf(acc[9])); w1.y = pk2(siluf(acc[10]), siluf(acc[11])); w1.z = pk2(siluf(acc[12]), siluf(acc[13])); w1.w = pk2(siluf(acc[14]), siluf(acc[15]));
              *(u32x4*)(xc + (size_t)row * 1024 + 16 * lane) = w0; *(u32x4*)(xc + (size_t)row * 1024 + 16 * lane + 8) = w1; }
        }
        for (int i = blockIdx.x * NTHR + tid; i < 32 * 48 * 128; i += G * NTHR) { const int bh = i / (48 * 128), rem = i % (48 * 128); Kn[((size_t)bh * LK + LTOT) * 128 + rem] = 0; }
        for (int i = blockIdx.x * NTHR + tid; i < 4 * 48 * 64; i += G * NTHR) { const int bb = i / (48 * 64), rem = i % (48 * 64); Kr[((size_t)bb * LK + LTOT) * 64 + rem] = 0; }
        for (int i = blockIdx.x * NTHR + tid; i < 32 * 128 * 48; i += G * NTHR) { const int bhd = i / 48, rem = i % 48; Vt[(size_t)bhd * LK + LTOT + rem] = 0; }
    }
    xcd_barrier(xbar);
    { PHASE_VARS const int fr = lane & 15, fq = lane >> 4; const bf16_t* WgT = (const bf16_t*)(ws + WS_WGT); LAS float* red = (LAS float*)lds;
      for (int bu = blockIdx.x; bu < MROWS / 16; bu += G) { const int r0 = bu * 16;
          const f32x4 a = wave < 4 ? skinny16(xc + (size_t)r0 * 1024 + wave * 256, 1024, WgT + wave * 256, 2048, 256, fr, fq)
                                   : skinny16(ub + (size_t)r0 * UW + O4 + (wave - 4) * 256, UW, WgT + wave * 256, 2048, 256, fr, fq);
#pragma unroll
          for (int j = 0; j < 4; ++j) red[(wave * 16 + 4 * fq + j) * 16 + fr] = a[j];
          __syncthreads();
          if (tid < 256) { float sv = args.in[I_BG][tid & 15];
#pragma unroll
              for (int w = 0; w < 8; ++w) sv += red[w * 256 + tid];
              if (((tid & 15) >> 2) & 1) sv = fminf(sv, 0.f) - log1pf(__expf(-fabsf(sv)));
              gates[(size_t)(r0 + (tid >> 4)) * 16 + (tid & 15)] = sv; }
          __syncthreads(); } }
    xcd_barrier(xbar);
    { PHASE_VARS
      for (int task = gw * 2 + (lane >> 5); task < 32 * 129; task += NGW * 2) { const int sq = task / 129, st = task - sq * 129, dir = sq & 1;
          if (st < (dir ? 128 : 129)) ml_table_task(gates, (float*)(ws + WS_TAB) + (size_t)sq * 129 * 128, sq >> 3, (sq >> 1) & 3, dir, st, lane); } }
    { pg8::Gemm g{512, 512, 512}; pg8::Sched S; S.init(TR / 256, 6, 1, G, blockIdx.x, qn, ws + WS_WUQ, 0, 0, 1, 512, 512);
      pg8::EpiQ E{Qb, rope}; pg8::gemm_phase<false, GEMM_ALIGN>(lds, g, S, E, wave_u); }
    { pg8::Gemm g{256, 256, 256}; pg8::Sched S; S.init(MR / 256, 4, 1, G, (blockIdx.x + 128) % G, kvn, ws + WS_WK, 0, 0, 1, 256, 256);
      pg8::EpiKn E{Kn}; pg8::gemm_phase<false, GEMM_ALIGN>(lds, g, S, E, wave_u); }
    { pg8::Gemm g{256, 256, 256}; pg8::Sched S; S.init(4, MR / 256, 1, G, (blockIdx.x + 120) % G, ws + WS_WV, kvn, 0, 0, 1, 256, 256);
      pg8::EpiVt E{Vt}; pg8::gemm_phase<false, GEMM_ALIGN>(lds, g, S, E, wave_u); }
    { pg8::Gemm g{256, 1024, 256}; pg8::Sched S; S.init(MR / 256, 1, 8, G, (blockIdx.x + 112) % G, xc, ws + WS_WMQ, 512, 131072, 4, 1024, 256);
      pg8::EpiBf16 E{mq, 256, (size_t)MR * 256, 1 << 30, 1.f}; pg8::gemm_phase<false, GEMM_ALIGN>(lds, g, S, E, wave_u); }
    { pg8::Gemm g{256, 256, 1024}; pg8::Sched S; S.init(1, MR / 256, 4, G, (blockIdx.x + 104) % G, ws + WS_WMKN, xc, 131072, 512, 4, 256, 1024);
      pg8::EpiBf16 E{mkT, MR, (size_t)256 * MR, 1 << 30, 1.f}; pg8::gemm_phase<false, GEMM_ALIGN>(lds, g, S, E, wave_u); }
    { pg8::Gemm g{256, 256, UW}; pg8::Sched S; S.init(1, MR / 256, 4, G, (blockIdx.x + 96) % G, ws + WS_WMV, ub + O4, 131072, 512, 4, 256, UW);
      pg8::EpiBf16 E{mvT, MR, (size_t)256 * MR, 1 << 30, 1.f}; pg8::gemm_phase<false, GEMM_ALIGN>(lds, g, S, E, wave_u); }
    xcd_barrier(xbar);
    {
        PHASE_VARS
        if (blockIdx.x < 64) { const int uid = blockIdx.x; mlstm_unit(lds, mq, mk, mkT, mvT, gates, ((uid >> 1) & 1) ? hb : hf, (float*)(ws + WS_TAB) + (size_t)(uid >> 1) * 129 * 128, (const void*)(ws + 1024), uid >> 4, (uid >> 2) & 3, (uid >> 1) & 1, uid & 1, wave_u); }
        LAS int* uslot = (LAS int*)(lds + 140000);
        const int tid2 = wave_u * 64 + lane_id_v();
        for (;;) {
            __syncthreads();
            if (tid2 == 0) *uslot = (int)atomicAdd(ctl, 1u);
            __syncthreads();
            const int uid = *uslot;
            if (uid >= 512) break;
            attn_unit(lds, Qb, Kn, Kr, Vt, oatt, uid >> 7, (uid >> 4) & 7, uid & 15, wave_u);
        }
    }
    xcd_barrier(xbar);
    { PHASE_VARS
    for (int row = gw; row < TR; row += NGW) {
        { const bf16_t* op = oatt + (size_t)row * 1024 + 16 * lane; const u32x4 v0 = __builtin_nontemporal_load((const u32x4*)op), v1 = __builtin_nontemporal_load((const u32x4*)(op + 8));
          float f[16] = {bflo(v0.x), bfhi(v0.x), bflo(v0.y), bfhi(v0.y), bflo(v0.z), bfhi(v0.z), bflo(v0.w), bfhi(v0.w), bflo(v1.x), bfhi(v1.x), bflo(v1.y), bfhi(v1.y), bflo(v1.z), bfhi(v1.z), bflo(v1.w), bfhi(v1.w)};
          float ss = 0.f;
#pragma unroll
          for (int i = 0; i < 16; ++i) ss += f[i] * f[i];
          const float rms = 1.f / sqrtf(wave_sum(ss) * (1.f / 1024.f) + 1e-6f); const float* og = args.in[I_AOG] + 16 * lane;
          u32x4 w0, w1;
          w0.x = pk2(f[0] * rms * og[0], f[1] * rms * og[1]); w0.y = pk2(f[2] * rms * og[2], f[3] * rms * og[3]); w0.z = pk2(f[4] * rms * og[4], f[5] * rms * og[5]); w0.w = pk2(f[6] * rms * og[6], f[7] * rms * og[7]);
          w1.x = pk2(f[8] * rms * og[8], f[9] * rms * og[9]); w1.y = pk2(f[10] * rms * og[10], f[11] * rms * og[11]); w1.z = pk2(f[12] * rms * og[12], f[13] * rms * og[13]); w1.w = pk2(f[14] * rms * og[14], f[15] * rms * og[15]);
          *(u32x4*)(ycat + (size_t)row * DM + 16 * lane) = w0; *(u32x4*)(ycat + (size_t)row * DM + 16 * lane + 8) = w1; }
#pragma unroll
        for (int hd = 0; hd < 4; ++hd) { const int c = hd * 256 + 4 * lane;
            const u32x2 a = __builtin_nontemporal_load((const u32x2*)(hf + (size_t)row * 1024 + c)), bq = __builtin_nontemporal_load((const u32x2*)(hb + (size_t)row * 1024 + c)), zz = *(const u32x2*)(ub + (size_t)row * UW + O5 + c), xx = *(const u32x2*)(xc + (size_t)row * 1024 + c);
            float hv[4] = {bflo(a.x) + bflo(bq.x), bfhi(a.x) + bfhi(bq.x), bflo(a.y) + bflo(bq.y), bfhi(a.y) + bfhi(bq.y)};
            const float zf[4] = {bflo(zz.x), bfhi(zz.x), bflo(zz.y), bfhi(zz.y)}, xf[4] = {bflo(xx.x), bfhi(xx.x), bflo(xx.y), bfhi(xx.y)};
#pragma unroll
            for (int i = 0; i < 4; ++i) hv[i] *= sigmf(zf[i]);
            const float mu = wave_sum(hv[0] + hv[1] + hv[2] + hv[3]) * (1.f / 256.f);
            float s2 = 0.f;
#pragma unroll
            for (int i = 0; i < 4; ++i) { hv[i] -= mu; s2 += hv[i] * hv[i]; }
            const float rstd = 1.f / sqrtf(wave_sum(s2) * (1.f / 256.f) + 1e-5f);
            const float* gg = args.in[I_GNG] + c; const float* sk = args.in[I_SKIP] + c;
            u32x2 w; w.x = pk2(hv[0] * rstd * gg[0] + sk[0] * xf[0], hv[1] * rstd * gg[1] + sk[1] * xf[1]); w.y = pk2(hv[2] * rstd * gg[2] + sk[2] * xf[2], hv[3] * rstd * gg[3] + sk[3] * xf[3]);
            *(u32x2*)(ycat + (size_t)row * DM + 1024 + c) = w; }
    } }
    xcd_barrier(xbar);
    { pg8::Gemm g{DM, DM, DM}; pg8::Sched S; S.init(TR / 256, 8, 1, G, blockIdx.x, ycat, ws + WS_WOUT, 0, 0, 1, DM, DM);
      pg8::EpiResid E{h1, (bf16_t*)args.out, 1.0f}; pg8::gemm_phase<GEMM_SP2, GEMM_ALIGN>(lds, g, S, E, wave_u); }
    xcd_barrier(xbar);
    { PHASE_VARS
    for (int row = gw; row < TR; row += NGW) ln_row_b((const bf16_t*)args.out + (size_t)row * DM, args.in[I_LN2G], args.in[I_LN2B], h2 + (size_t)row * DM, nullptr, lane);
    ffn_weights(args.in[I_F2G], args.in[I_F2U], args.in[I_F2D], ws, scr, gw, NGW, lane); }
    xcd_barrier(xbar);
    { pg8::Gemm g{DM, DM, DM}; pg8::Sched S; S.init(TR / 256, 44, 1, G, blockIdx.x, h2, ws + WS_WGU, 0, 0, 1, DM, DM);
      pg8::EpiSwiGLU E{Gb}; pg8::gemm_phase<GEMM_SP2, GEMM_ALIGN>(lds, g, S, E, wave_u); }
    xcd_barrier(xbar);
    { pg8::Gemm g{FF, FF, FF}; pg8::Sched S; S.init(TR / 256, 8, 1, G, blockIdx.x, Gb, ws + WS_WD, 0, 0, 1, FF, FF);
      pg8::EpiResid E{h2, (bf16_t*)(ws + WS_RM), 0.5f}; pg8::gemm_phase<GEMM_SP2, GEMM_ALIGN>(lds, g, S, E, wave_u); }
    xcd_barrier(xbar);
    { PHASE_VARS
    for (int row = gw; row < TR; row += NGW) ln_row_b((const bf16_t*)(ws + WS_RM) + (size_t)row * DM, args.in[I_LN3G], args.in[I_LN3B], nullptr, args.out + (size_t)row * DM, lane); }
}

extern "C" void kernel_launch(void* const* d_in, const int* in_sizes, int n_in, void* d_out, int out_size, void* d_ws, size_t ws_size, hipStream_t stream) {
    static int grid = 0;
    if (grid == 0) {
        if (n_in != 30 || out_size != TR * DM || ws_size < WS_END) { fprintf(stderr, "kernel_launch: unexpected shapes (n_in %d out %d ws %zu need %zu)\n", n_in, out_size, ws_size, (size_t)WS_END); grid = -1; return; }
        int dev = 0, cus = 0, per_cu = 0;
        if (hipGetDevice(&dev) != hipSuccess || hipDeviceGetAttribute(&cus, hipDeviceAttributeMultiprocessorCount, dev) != hipSuccess) { grid = -1; return; }
        if (hipFuncSetAttribute((const void*)fwd_mega, hipFuncAttributeMaxDynamicSharedMemorySize, LDS_BYTES) != hipSuccess) { fprintf(stderr, "hipFuncSetAttribute failed\n"); grid = -1; return; }
        if (hipOccupancyMaxActiveBlocksPerMultiprocessor(&per_cu, (const void*)fwd_mega, NTHR, LDS_BYTES) != hipSuccess || per_cu < 1) fprintf(stderr, "occupancy query: %d\n", per_cu);
        (void)hipGetLastError();
        grid = cus;
        if (grid < 64) { fprintf(stderr, "grid too small\n"); grid = -1; }
    }
    if (grid < 0) return;
    Args a{};
    for (int i = 0; i < 30; ++i) a.in[i] = (const float*)d_in[i];
    a.out = (float*)d_out; a.wsp = (unsigned char*)d_ws;
    (void)hipMemsetAsync(d_ws, 0, 4096 + 16384, stream);
    void* params[] = {&a};
    hipError_t e = hipLaunchCooperativeKernel((const void*)fwd_mega, dim3(grid), dim3(NTHR), params, LDS_BYTES, stream);
    if (e != hipSuccess) fprintf(stderr, "cooperative launch failed: %s (grid %d)\n", hipGetErrorString(e), grid);
}
```

```cpp
#include <hip/hip_runtime.h>
#include <hip/hip_cooperative_groups.h>
#include <cstdio>
#include <cstdint>
namespace cg = cooperative_groups;
#ifndef GEMM_SP2
#define GEMM_SP2 true
#endif
#ifndef GEMM_ALIGN
#define GEMM_ALIGN true
#endif

#define LAS __attribute__((address_space(3)))
typedef unsigned short bf16_t;
typedef short bf16x8 __attribute__((ext_vector_type(8)));
typedef short s16x4 __attribute__((ext_vector_type(4)));
typedef float f32x4 __attribute__((ext_vector_type(4)));
typedef float f32x2 __attribute__((ext_vector_type(2)));
typedef float f32x16 __attribute__((ext_vector_type(16)));
typedef unsigned u32x4 __attribute__((ext_vector_type(4)));
typedef unsigned u32x2 __attribute__((ext_vector_type(2)));

constexpr int DM = 2048, FF = 5632, TR = 16384, MR = 16640, MROWS = 16448, SEQ = 4096, LK = 4160, LTOT = 4112;
constexpr int UW = 3072, O2 = 512, O3 = 768, O4 = 832, O5 = 1856;
constexpr float ALPHA = 1.189207115002721f;
constexpr float QSCALE = 0.07216878364870322f * 1.4426950408889634f;
constexpr int LDS_BYTES = 147456;
constexpr int NTHR = 512;

constexpr size_t WS_CTL = 0;
constexpr size_t WS_BAR = 4096;
constexpr size_t WS_ROPE = 4096 + 16384;
constexpr size_t WS_ZMETA = WS_ROPE + 1052672;
constexpr size_t WS_WIN = WS_ZMETA + 2097152;
constexpr size_t WS_WUQ = WS_WIN + 12582912;
constexpr size_t WS_WK = WS_WUQ + 1572864;
constexpr size_t WS_WV = WS_WK + 524288;
constexpr size_t WS_WMQ = WS_WV + 524288;
constexpr size_t WS_WMK = WS_WMQ + 524288;
constexpr size_t WS_WMV = WS_WMK + 524288;
constexpr size_t WS_WOUT = WS_WMV + 524288;
constexpr size_t WS_KROPE = WS_WOUT + 8388608;
constexpr size_t WS_RW = WS_KROPE + 2129920;
constexpr size_t WS_WGU = WS_RW, WS_WD = WS_RW + 46137344;
constexpr size_t WS_QN = WS_RW, WS_KVN = WS_QN + 17039360, WS_XC = WS_KVN + 8519680, WS_GATES = WS_XC + 34078720;
constexpr size_t WS_RH0 = WS_RW + 69206016;
constexpr size_t WS_H0 = WS_RH0, WS_KN = WS_RH0, WS_VT = WS_RH0 + 34078720, WS_H2 = WS_RH0;
constexpr size_t WS_RG = WS_RH0 + 68157440;
constexpr size_t WS_G = WS_RG, WS_U = WS_RG, WS_OATT = WS_U + 102236160, WS_MKT = WS_OATT + 33554432;
constexpr size_t WS_H1 = WS_RG + 187432960;
constexpr size_t WS_RM = WS_H1 + 68157440;
constexpr size_t WS_MQ = WS_RM, WS_MK = WS_MQ + 34078720, WS_MVT = WS_MK + 34078720, WS_YCAT = WS_RM;
constexpr size_t WS_WGT = WS_RM + 102236160;
constexpr size_t WS_TAB = WS_WGT + 65536;
constexpr size_t WS_WMKN = WS_TAB + 64 * 129 * 512;
constexpr size_t WS_END = WS_WMKN + 524288;
static_assert(WS_MKT + 34078720 <= WS_H1, "RG overlay");
static_assert(WS_GATES + 1064960 <= WS_RH0, "RW overlay");
static_assert(WS_END <= 536870912ull, "workspace");
constexpr size_t DO_Q = 0, DO_HF = 50331648, DO_HB = DO_HF + 33554432;

__device__ __forceinline__ unsigned f2bf(float f) { unsigned u = __builtin_bit_cast(unsigned, f); return (u + 0x7fffu + ((u >> 16) & 1u)) >> 16; }
typedef __bf16 bf16x2_t __attribute__((ext_vector_type(2)));
__device__ __forceinline__ unsigned cvtpk(float lo, float hi) { const f32x2 v = {lo, hi}; const bf16x2_t b = __builtin_convertvector(v, bf16x2_t); return __builtin_bit_cast(unsigned, b); }
__device__ __forceinline__ unsigned pk2(float lo, float hi) { return cvtpk(lo, hi); }
__device__ __forceinline__ float bflo(unsigned u) { return __builtin_bit_cast(float, u << 16); }
__device__ __forceinline__ float bfhi(unsigned u) { return __builtin_bit_cast(float, u & 0xffff0000u); }
__device__ __forceinline__ float bf1(bf16_t h) { return __builtin_bit_cast(float, (unsigned)h << 16); }
__device__ __forceinline__ float wave_sum(float v) {
#pragma unroll
    for (int o = 1; o < 64; o <<= 1) v += __shfl_xor(v, o);
    return v;
}
__device__ __forceinline__ float siluf(float x) { return x * __builtin_amdgcn_rcpf(1.f + __builtin_amdgcn_exp2f(-1.4426950408889634f * x)); }
__device__ __forceinline__ float sigmf(float x) { return __builtin_amdgcn_rcpf(1.f + __builtin_amdgcn_exp2f(-1.4426950408889634f * x)); }
__device__ __forceinline__ int lane_id_v() { int l; asm volatile("v_mbcnt_lo_u32_b32 %0, -1, 0\n\tv_mbcnt_hi_u32_b32 %0, -1, %0" : "=v"(l)); return l; }
__device__ __forceinline__ float shx(float v, int lane, int m) { return __builtin_bit_cast(float, __builtin_amdgcn_ds_bpermute((lane ^ m) << 2, __builtin_bit_cast(int, v))); }
__device__ __forceinline__ float shl(float v, int src) { return __builtin_bit_cast(float, __builtin_amdgcn_ds_bpermute(src << 2, __builtin_bit_cast(int, v))); }
#define LDS_WAIT() asm volatile("s_waitcnt lgkmcnt(0)" ::: "memory")

namespace pg8 {
constexpr int BM = 256, BK = 64, HALF = 128, HTB = HALF * BK * 2, STAGE_BYTES = 8 * HTB, NXCD = 8, WGM = 8;
__host__ __device__ __forceinline__ int lds_byte(int r, int c) { const int st = (r >> 4) * 2 + (c >> 5), rr = r & 15, cc = c & 31, ob = rr * 64 + cc * 2; return st * 1024 + (ob ^ (((ob >> 9) & 1) << 5)); }
__host__ __device__ __forceinline__ void stage_rc(int b, int& R, int& C) { const int st = b / 1024, sb = b % 1024, swz = sb ^ (((sb >> 9) & 1) << 5); R = (st >> 1) * 16 + swz / 64; C = (st & 1) * 32 + (swz % 64) / 2; }
__host__ __device__ __forceinline__ int perm32(int rho) { const int n = rho >> 4, i = rho & 15; return 8 * (i >> 2) + 4 * n + (i & 3); }

struct Unit { int pm, pn, g; const char* a; const char* b; };
__device__ __forceinline__ const char* uptr(const char* p) { const unsigned long long v = (unsigned long long)p; const unsigned lo = __builtin_amdgcn_readfirstlane((unsigned)v), hi = __builtin_amdgcn_readfirstlane((unsigned)(v >> 32)); return (const char*)(((unsigned long long)hi << 32) | lo); }
struct Gemm { int K, lda, ldb; };

struct Sched {
    int nM, nN, nwg, total, G, c; const char* A0; const char* B0; size_t aG, bG, tA, tB; int gmodA;
    __device__ void init(int nM_, int nN_, int ngrp, int G_, int c_, const void* A0_, const void* B0_, size_t aG_, size_t bG_, int gmodA_, int lda, int ldb) {
        nM = nM_; nN = nN_; nwg = nM * nN; total = nwg * ngrp; G = G_; c = c_; A0 = (const char*)A0_; B0 = (const char*)B0_; aG = aG_; bG = bG_; gmodA = gmodA_;
        tA = (size_t)256 * lda * 2; tB = (size_t)256 * ldb * 2;
    }
    __device__ bool next(int i, Unit& u) const {
        const int L = i * G + c; if (L >= total) return false;
        const int g = L / nwg; int wgid = L - g * nwg;
        { const int q = nwg / NXCD, r = nwg % NXCD, xcd = wgid % NXCD, off = wgid / NXCD; wgid = (xcd < r ? xcd * (q + 1) : r * (q + 1) + (xcd - r) * q) + off; }
        const int nig = WGM * nN, gid = wgid / nig, fm = gid * WGM, gsz = (nM - fm) < WGM ? (nM - fm) : WGM;
        u.pm = __builtin_amdgcn_readfirstlane(fm + ((wgid % nig) % gsz)); u.pn = __builtin_amdgcn_readfirstlane((wgid % nig) / gsz); u.g = __builtin_amdgcn_readfirstlane(g);
        u.a = uptr(A0 + (size_t)(u.g % gmodA) * aG + (size_t)u.pm * tA); u.b = uptr(B0 + (size_t)u.g * bG + (size_t)u.pn * tB);
        return true;
    }
};

__device__ __forceinline__ unsigned cvt_pk_bf16(float lo, float hi) { unsigned r; asm volatile("v_cvt_pk_bf16_f32 %0, %1, %2" : "=v"(r) : "v"(lo), "v"(hi)); return r; }

template <bool SP2, bool ALIGN_EPI, class Epi>
__device__ __forceinline__ void gemm_phase(LAS unsigned char* lds, const Gemm g, const Sched& S, const Epi& E, int wave_u) {
    int tid = wave_u * 64 + lane_id_v();
    const int wid = __builtin_amdgcn_readfirstlane(tid >> 6), lane = tid & 63, wr = wid >> 2, wc = wid & 3, fr = lane & 15, fq = lane >> 4;
    const int K = g.K, nt = K / BK;
    unsigned voffA[2], voffB[2];
#pragma unroll
    for (int i = 0; i < 2; ++i) { int R, C; stage_rc(tid * 16 + i * 8192, R, C); const int Rb = (R & ~31) + perm32(R & 31);
        voffA[i] = (unsigned)(R * g.lda + C) * 2u; voffB[i] = (unsigned)(Rb * g.ldb + C) * 2u; }
    const size_t kstep = (size_t)(BK * 2);
    const size_t hstepA = (size_t)HALF * g.lda * 2, hstepB = (size_t)HALF * g.ldb * 2;
    const unsigned ldsw = (unsigned)wid * 1024u;
    const int aoff = lds_byte(wr * 64 + fr, fq * 8), boff = lds_byte(wc * 32 + fr, fq * 8);
#define PG8_SA(b, h) (((b) * 2 + (h)) * HTB)
#define PG8_SB(b, h) ((4 + (b) * 2 + (h)) * HTB)
#define PG8_STAGE(bufoff, gbase, voff) do { _Pragma("unroll") for (int _i = 0; _i < 2; ++_i) \
        __builtin_amdgcn_global_load_lds((const unsigned*)((const char*)(gbase) + (voff)[_i]), (LAS unsigned*)(lds + (bufoff) + ldsw + _i * 8192), 16, 0, 0); } while (0)
#define PG8_LDA(dst, b, h) do { _Pragma("unroll") for (int m = 0; m < 4; ++m) _Pragma("unroll") for (int k = 0; k < 2; ++k) dst[m][k] = *(const LAS bf16x8*)(lds + PG8_SA(b, h) + aoff + m * 2048 + k * 1024); } while (0)
#define PG8_LDB(dst, b, h) do { _Pragma("unroll") for (int n = 0; n < 2; ++n) _Pragma("unroll") for (int k = 0; k < 2; ++k) dst[n][k] = *(const LAS bf16x8*)(lds + PG8_SB(b, h) + boff + n * 2048 + k * 1024); } while (0)
#define PG8_MMA(ai, bj, At, Bt) do { __builtin_amdgcn_s_setprio(1); _Pragma("unroll") for (int m = 0; m < 4; ++m) _Pragma("unroll") for (int n = 0; n < 2; ++n) _Pragma("unroll") for (int k = 0; k < 2; ++k) \
        acc[ai][bj][m][n] = __builtin_amdgcn_mfma_f32_16x16x32_bf16(Bt[n][k], At[m][k], acc[ai][bj][m][n], 0, 0, 0); __builtin_amdgcn_s_setprio(0); } while (0)
#define PG8_WAIT_V(n) asm volatile("s_waitcnt vmcnt(" #n ")" ::: "memory")
#define PG8_WAIT_L(n) asm volatile("s_waitcnt lgkmcnt(" #n ")" ::: "memory")
#define PG8_BAR __builtin_amdgcn_s_barrier()
#define PG8_SCHED __builtin_amdgcn_sched_barrier(0)
    Unit cur, nxt; int ui = 0;
    if (!S.next(0, cur)) return;
    f32x4 acc[2][2][4][2];
#pragma unroll
    for (int a = 0; a < 2; ++a)
#pragma unroll
        for (int b = 0; b < 2; ++b)
#pragma unroll
            for (int m = 0; m < 4; ++m)
#pragma unroll
                for (int n = 0; n < 2; ++n) acc[a][b][m][n] = (f32x4){0.f, 0.f, 0.f, 0.f};
    bf16x8 At[4][2], B0[2][2], B1[2][2];
    const char* cA = cur.a; const char* cB = cur.b;
    if constexpr (SP2) {
        PG8_STAGE(PG8_SB(0, 0), cB, voffB); PG8_STAGE(PG8_SB(0, 1), cB + hstepB, voffB); PG8_STAGE(PG8_SA(0, 0), cA, voffA); PG8_STAGE(PG8_SA(0, 1), cA + hstepA, voffA);
        if (wr == 1) PG8_BAR;
        PG8_WAIT_V(2); PG8_BAR;
        PG8_STAGE(PG8_SB(1, 0), cB + kstep, voffB); PG8_STAGE(PG8_SA(1, 0), cA + kstep, voffA); PG8_STAGE(PG8_SB(1, 1), cB + hstepB + kstep, voffB);
        PG8_WAIT_V(6); PG8_BAR;
    } else {
        PG8_STAGE(PG8_SB(0, 0), cB, voffB); PG8_STAGE(PG8_SA(0, 0), cA, voffA); PG8_STAGE(PG8_SB(0, 1), cB + hstepB, voffB); PG8_STAGE(PG8_SA(0, 1), cA + hstepA, voffA);
        if (wr == 1) PG8_BAR;
        PG8_WAIT_V(4); PG8_BAR;
        PG8_STAGE(PG8_SB(1, 0), cB + kstep, voffB); PG8_STAGE(PG8_SA(1, 0), cA + kstep, voffA); PG8_STAGE(PG8_SB(1, 1), cB + hstepB + kstep, voffB);
        PG8_WAIT_V(6); PG8_BAR;
    }
    for (;;) {
        const bool has_next = S.next(ui + 1, nxt);
        const char* nA = has_next ? nxt.a : cA; const char* nB = has_next ? nxt.b : cB;
#pragma unroll 1
        for (int t = 0; t < nt; t += 2) {
            const bool last = (t == nt - 2);
            const char* a1 = cA + (size_t)(t + 1) * kstep;
            const char* a2 = last ? nA : cA + (size_t)(t + 2) * kstep; const char* b2 = last ? nB : cB + (size_t)(t + 2) * kstep;
            const char* a3 = a2 + kstep; const char* b3 = b2 + kstep;
            if constexpr (SP2) {
            PG8_LDB(B0, 0, 0); PG8_LDB(B1, 0, 1); PG8_SCHED; PG8_LDA(At, 0, 0); PG8_STAGE(PG8_SA(1, 1), a1 + hstepA, voffA);
            PG8_WAIT_V(8); PG8_WAIT_L(0); PG8_BAR; PG8_MMA(0, 0, At, B0); PG8_MMA(0, 1, At, B1); PG8_BAR; PG8_SCHED;
            PG8_LDA(At, 0, 1); PG8_STAGE(PG8_SB(0, 0), b2, voffB); PG8_STAGE(PG8_SB(0, 1), b2 + hstepB, voffB); PG8_STAGE(PG8_SA(0, 0), a2, voffA);
            PG8_WAIT_V(8); PG8_WAIT_L(0); PG8_BAR; PG8_MMA(1, 0, At, B0); PG8_MMA(1, 1, At, B1); PG8_BAR; PG8_SCHED;
            PG8_LDB(B0, 1, 0); PG8_LDB(B1, 1, 1); PG8_SCHED; PG8_LDA(At, 1, 0); PG8_STAGE(PG8_SA(0, 1), a2 + hstepA, voffA);
            PG8_WAIT_V(8); PG8_WAIT_L(0); PG8_BAR; PG8_MMA(0, 0, At, B0); PG8_MMA(0, 1, At, B1); PG8_BAR; PG8_SCHED;
            PG8_LDA(At, 1, 1); PG8_STAGE(PG8_SB(1, 0), b3, voffB); PG8_STAGE(PG8_SB(1, 1), b3 + hstepB, voffB); PG8_STAGE(PG8_SA(1, 0), a3, voffA);
            PG8_WAIT_V(8); PG8_WAIT_L(0); PG8_BAR; PG8_MMA(1, 0, At, B0); PG8_MMA(1, 1, At, B1); PG8_BAR; PG8_SCHED;
            } else {
            PG8_LDB(B0, 0, 0); PG8_SCHED; PG8_LDA(At, 0, 0); PG8_STAGE(PG8_SA(1, 1), a1 + hstepA, voffA);
            PG8_WAIT_L(8); PG8_BAR; PG8_WAIT_L(0); PG8_MMA(0, 0, At, B0); PG8_BAR; PG8_SCHED;
            PG8_LDB(B1, 0, 1); PG8_STAGE(PG8_SB(0, 0), b2, voffB);
            PG8_BAR; PG8_WAIT_L(0); PG8_MMA(0, 1, At, B1); PG8_BAR;
            PG8_LDA(At, 0, 1); PG8_STAGE(PG8_SA(0, 0), a2, voffA);
            PG8_BAR; PG8_WAIT_L(0); PG8_MMA(1, 0, At, B0); PG8_BAR; PG8_SCHED;
            PG8_STAGE(PG8_SB(0, 1), b2 + hstepB, voffB);
            PG8_WAIT_V(6); PG8_BAR; PG8_MMA(1, 1, At, B1); PG8_BAR;
            PG8_LDB(B0, 1, 0); PG8_SCHED; PG8_LDA(At, 1, 0); PG8_STAGE(PG8_SA(0, 1), a2 + hstepA, voffA);
            PG8_WAIT_L(8); PG8_BAR; PG8_WAIT_L(0); PG8_MMA(0, 0, At, B0); PG8_BAR; PG8_SCHED;
            PG8_LDB(B1, 1, 1); PG8_STAGE(PG8_SB(1, 0), b3, voffB);
            PG8_BAR; PG8_WAIT_L(0); PG8_MMA(0, 1, At, B1); PG8_BAR;
            PG8_LDA(At, 1, 1); PG8_STAGE(PG8_SA(1, 0), a3, voffA);
            PG8_BAR; PG8_WAIT_L(0); PG8_MMA(1, 0, At, B0); PG8_BAR; PG8_SCHED;
            PG8_STAGE(PG8_SB(1, 1), b3 + hstepB, voffB);
            PG8_WAIT_V(6); PG8_BAR; PG8_MMA(1, 1, At, B1); PG8_BAR;
            }
        }
        if constexpr (ALIGN_EPI) { if (wr == 0) PG8_BAR; }
        E(acc, cur, wr, wc, fr, fq);
        if (!has_next) break;
#pragma unroll
        for (int a = 0; a < 2; ++a)
#pragma unroll
            for (int b = 0; b < 2; ++b)
#pragma unroll
                for (int m = 0; m < 4; ++m)
#pragma unroll
                    for (int n = 0; n < 2; ++n) acc[a][b][m][n] = (f32x4){0.f, 0.f, 0.f, 0.f};
        cur = nxt; cA = nA; cB = nB; ++ui;
        if constexpr (ALIGN_EPI) { if (wr == 1) PG8_BAR; }
    }
    PG8_WAIT_V(0);
    if constexpr (!ALIGN_EPI) { if (wr == 0) PG8_BAR; }
    PG8_BAR;
#undef PG8_SA
#undef PG8_SB
#undef PG8_STAGE
#undef PG8_LDA
#undef PG8_LDB
#undef PG8_MMA
#undef PG8_WAIT_V
#undef PG8_WAIT_L
#undef PG8_BAR
#undef PG8_SCHED
}

#define EPI_LOOP_ROWS for (int ai = 0; ai < 2; ++ai) for (int m = 0; m < 4; ++m, __builtin_amdgcn_sched_barrier(0))
struct EpiSwiGLU {
    bf16_t* G;
    __device__ __forceinline__ void operator()(const f32x4 (&acc)[2][2][4][2], const Unit& u, int wr, int wc, int fr, int fq) const {
        const int col = u.pn * 128 + wc * 32 + fq * 8;
#pragma unroll
        EPI_LOOP_ROWS { const int row = u.pm * 256 + ai * 128 + wr * 64 + m * 16 + fr;
            float o[8];
#pragma unroll
            for (int n = 0; n < 2; ++n)
#pragma unroll
                for (int j = 0; j < 4; ++j) o[n * 4 + j] = siluf(acc[ai][0][m][n][j]) * acc[ai][1][m][n][j];
            u32x4 w; w.x = pk2(o[0], o[1]); w.y = pk2(o[2], o[3]); w.z = pk2(o[4], o[5]); w.w = pk2(o[6], o[7]);
            *(u32x4*)(G + (size_t)row * FF + col) = w; }
    }
};
struct EpiResid {
    const bf16_t* res; bf16_t* zb; float sc;
    __device__ __forceinline__ void operator()(const f32x4 (&acc)[2][2][4][2], const Unit& u, int wr, int wc, int fr, int fq) const {
#pragma unroll
        EPI_LOOP_ROWS { const int row = u.pm * 256 + ai * 128 + wr * 64 + m * 16 + fr;
#pragma unroll
            for (int bj = 0; bj < 2; ++bj) { const int col = u.pn * 256 + bj * 128 + wc * 32 + fq * 8;
                const u32x4 rv = *(const u32x4*)(res + (size_t)row * DM + col);
                u32x4 w;
                w.x = pk2(ALPHA * bflo(rv.x) + sc * acc[ai][bj][m][0][0], ALPHA * bfhi(rv.x) + sc * acc[ai][bj][m][0][1]);
                w.y = pk2(ALPHA * bflo(rv.y) + sc * acc[ai][bj][m][0][2], ALPHA * bfhi(rv.y) + sc * acc[ai][bj][m][0][3]);
                w.z = pk2(ALPHA * bflo(rv.z) + sc * acc[ai][bj][m][1][0], ALPHA * bfhi(rv.z) + sc * acc[ai][bj][m][1][1]);
                w.w = pk2(ALPHA * bflo(rv.w) + sc * acc[ai][bj][m][1][2], ALPHA * bfhi(rv.w) + sc * acc[ai][bj][m][1][3]);
                *(u32x4*)(zb + (size_t)row * DM + col) = w; }
        }
    }
};
struct EpiBf16 {
    bf16_t* O; int ldc; size_t gstride; int gscale_from; float sc;
    __device__ __forceinline__ void operator()(const f32x4 (&acc)[2][2][4][2], const Unit& u, int wr, int wc, int fr, int fq) const {
        const float s = (u.g >= gscale_from) ? sc : 1.f;
        bf16_t* base = O + (size_t)u.g * gstride;
#pragma unroll
        EPI_LOOP_ROWS { const int row = u.pm * 256 + ai * 128 + wr * 64 + m * 16 + fr;
#pragma unroll
            for (int bj = 0; bj < 2; ++bj) { const int col = u.pn * 256 + bj * 128 + wc * 32 + fq * 8;
                const f32x4 v0 = acc[ai][bj][m][0] * s, v1 = acc[ai][bj][m][1] * s;
                u32x4 w; w.x = pk2(v0[0], v0[1]); w.y = pk2(v0[2], v0[3]); w.z = pk2(v1[0], v1[1]); w.w = pk2(v1[2], v1[3]);
                *(u32x4*)(base + (size_t)row * ldc + col) = w; }
        }
    }
};
struct EpiQ {
    bf16_t* Q; const f32x2* rope;
    __device__ __forceinline__ void operator()(const f32x4 (&acc)[2][2][4][2], const Unit& u, int wr, int wc, int fr, int fq) const {
#pragma unroll
        EPI_LOOP_ROWS { const int row = u.pm * 256 + ai * 128 + wr * 64 + m * 16 + fr;
            const int b = row >> 12, s = row & 4095;
            if (u.pn < 4) {
#pragma unroll
                for (int bj = 0; bj < 2; ++bj) { const int h = u.pn * 2 + bj, d = wc * 32 + fq * 8;
                    const f32x4 v0 = acc[ai][bj][m][0] * QSCALE, v1 = acc[ai][bj][m][1] * QSCALE;
                    u32x4 w; w.x = pk2(v0[0], v0[1]); w.y = pk2(v0[2], v0[3]); w.z = pk2(v1[0], v1[1]); w.w = pk2(v1[2], v1[3]);
                    *(u32x4*)(Q + ((size_t)(b * 8 + h) * SEQ + s) * 192 + d) = w; }
            } else {
                const int p0 = (u.pn - 4) * 128 + wc * 32 + fq * 8, h = p0 >> 5, i0 = p0 & 31;
                const f32x2* rp = rope + (size_t)(16 + s) * 32 + i0;
                float o1[8], o2[8];
#pragma unroll
                for (int n = 0; n < 2; ++n)
#pragma unroll
                    for (int j = 0; j < 4; ++j) { const f32x2 cs = rp[n * 4 + j]; const float x1 = acc[ai][0][m][n][j], x2 = acc[ai][1][m][n][j];
                        o1[n * 4 + j] = (x1 * cs.x - x2 * cs.y) * QSCALE; o2[n * 4 + j] = (x2 * cs.x + x1 * cs.y) * QSCALE; }
                bf16_t* qp = Q + ((size_t)(b * 8 + h) * SEQ + s) * 192 + 128 + i0;
                u32x4 w; w.x = pk2(o1[0], o1[1]); w.y = pk2(o1[2], o1[3]); w.z = pk2(o1[4], o1[5]); w.w = pk2(o1[6], o1[7]);
                *(u32x4*)qp = w;
                w.x = pk2(o2[0], o2[1]); w.y = pk2(o2[2], o2[3]); w.z = pk2(o2[4], o2[5]); w.w = pk2(o2[6], o2[7]);
                *(u32x4*)(qp + 32) = w;
            }
        }
    }
};
struct EpiKn {
    bf16_t* Kn;
    __device__ __forceinline__ void operator()(const f32x4 (&acc)[2][2][4][2], const Unit& u, int wr, int wc, int fr, int fq) const {
#pragma unroll
        EPI_LOOP_ROWS { const int row = u.pm * 256 + ai * 128 + wr * 64 + m * 16 + fr;
            if (row < MROWS) {
                int b, key; if (row < TR) { b = row >> 12; key = row & 4095; } else { b = (row - TR) >> 4; key = SEQ + ((row - TR) & 15); }
#pragma unroll
                for (int bj = 0; bj < 2; ++bj) { const int h = u.pn * 2 + bj, d = wc * 32 + fq * 8;
                    const f32x4 v0 = acc[ai][bj][m][0], v1 = acc[ai][bj][m][1];
                    u32x4 w; w.x = pk2(v0[0], v0[1]); w.y = pk2(v0[2], v0[3]); w.z = pk2(v1[0], v1[1]); w.w = pk2(v1[2], v1[3]);
                    *(u32x4*)(Kn + ((size_t)(b * 8 + h) * LK + key) * 128 + d) = w; }
            }
        }
    }
};
struct EpiVt {
    bf16_t* Vt;
    __device__ __forceinline__ void operator()(const f32x4 (&acc)[2][2][4][2], const Unit& u, int wr, int wc, int fr, int fq) const {
#pragma unroll
        EPI_LOOP_ROWS { const int f = u.pm * 256 + ai * 128 + wr * 64 + m * 16 + fr, h = f >> 7, d = f & 127;
#pragma unroll
            for (int bj = 0; bj < 2; ++bj) { const int row = u.pn * 256 + bj * 128 + wc * 32 + fq * 8;
                if (row < MROWS) {
                    int b, key; if (row < TR) { b = row >> 12; key = row & 4095; } else { b = (row - TR) >> 4; key = SEQ + ((row - TR) & 15); }
                    const f32x4 v0 = acc[ai][bj][m][0], v1 = acc[ai][bj][m][1];
                    u32x4 w; w.x = pk2(v0[0], v0[1]); w.y = pk2(v0[2], v0[3]); w.z = pk2(v1[0], v1[1]); w.w = pk2(v1[2], v1[3]);
                    bf16_t* vp = Vt + ((size_t)(b * 8 + h) * 128 + d) * LK + (key & ~15);
                    const int hi8 = (key >> 3) & 1;
                    *(u32x2*)(vp + (hi8 ? 4 : 0)) = (u32x2){w.x, w.y}; *(u32x2*)(vp + (hi8 ? 12 : 8)) = (u32x2){w.z, w.w}; }
            }
        }
    }
};
}

struct Args { const float* in[30]; float* out; unsigned char* wsp; };
enum { I_X = 0, I_META, I_F1G, I_F1U, I_F1D, I_LN1G, I_LN1B, I_WIN, I_QNG, I_WUQ, I_KVNG, I_WUKV, I_AOG, I_CW, I_CB, I_MWQ, I_MWK, I_MWV, I_WG, I_BG, I_GNG, I_SKIP,
       I_WOUT, I_LN2G, I_LN2B, I_F2G, I_F2U, I_F2D, I_LN3G, I_LN3B };

__device__ __forceinline__ int perm_qk(int n) { return n < 16 ? 8 * (n >> 2) + (n & 3) : 8 * ((n - 16) >> 2) + 4 + (n & 3); }
__device__ __forceinline__ void tr_item(const float* W, int N, bf16_t* WT, int ldt, int dst_row, int k0, int n0, LAS float* scr, int lane, float scale, bool perm = false) {
#pragma unroll 8
    for (int i = 0; i < 32; ++i) { const int kk = 2 * i + (lane >> 5); scr[kk * 33 + (lane & 31)] = __builtin_nontemporal_load(&W[(size_t)(k0 + kk) * N + n0 + (lane & 31)]); }
    LDS_WAIT(); asm volatile("" ::: "memory");
    const int c = lane & 7;
#pragma unroll
    for (int j = 0; j < 4; ++j) { const int n = (lane >> 3) + 8 * j; const LAS float* s = scr + (8 * c) * 33 + n;
        u32x4 o; o.x = pk2(s[0 * 33] * scale, s[1 * 33] * scale); o.y = pk2(s[2 * 33] * scale, s[3 * 33] * scale); o.z = pk2(s[4 * 33] * scale, s[5 * 33] * scale); o.w = pk2(s[6 * 33] * scale, s[7 * 33] * scale);
        *(u32x4*)(WT + (size_t)(dst_row + (perm ? perm_qk(n) : n)) * ldt + k0 + 8 * c) = o; }
    LDS_WAIT(); asm volatile("" ::: "memory");
}
__device__ __forceinline__ void ffn_weights(const float* Wg, const float* Wu, const float* Wd, unsigned char* ws, LAS float* scr, int gw, int NGW, int lane) {
    bf16_t* Wgu = (bf16_t*)(ws + WS_WGU); bf16_t* Wdt = (bf16_t*)(ws + WS_WD);
    for (int it = gw; it < 3 * 5632; it += NGW) {
        const int mat = it / 5632, r = it % 5632;
        if (mat < 2) { const int kb = r / 176, nb = r % 176, n0 = nb * 32; tr_item(mat ? Wu : Wg, FF, Wgu, DM, (n0 >> 7) * 256 + mat * 128 + (n0 & 127), kb * 64, n0, scr, lane, 1.f); }
        else { const int kb = r / 64, nb = r % 64; tr_item(Wd, DM, Wdt, FF, nb * 32, kb * 64, nb * 32, scr, lane, 1.f); }
    }
}
__device__ __forceinline__ void ln_row_b(const bf16_t* zr, const float* g, const float* bb, bf16_t* ob, float* of, int lane) {
    f32x4 v[8]; float s = 0.f;
#pragma unroll
    for (int j = 0; j < 4; ++j) { const u32x4 r = __builtin_nontemporal_load((const u32x4*)(zr + 8 * (lane + 64 * j)));
        v[2 * j] = (f32x4){bflo(r.x), bfhi(r.x), bflo(r.y), bfhi(r.y)}; v[2 * j + 1] = (f32x4){bflo(r.z), bfhi(r.z), bflo(r.w), bfhi(r.w)};
        s += (v[2 * j][0] + v[2 * j][1]) + (v[2 * j][2] + v[2 * j][3]) + (v[2 * j + 1][0] + v[2 * j + 1][1]) + (v[2 * j + 1][2] + v[2 * j + 1][3]); }
    const float mean = wave_sum(s) * (1.f / DM); float s2 = 0.f;
#pragma unroll
    for (int j = 0; j < 8; ++j) { v[j] = v[j] - mean; s2 += (v[j][0] * v[j][0] + v[j][1] * v[j][1]) + (v[j][2] * v[j][2] + v[j][3] * v[j][3]); }
    const float rstd = 1.f / sqrtf(wave_sum(s2) * (1.f / DM) + 1e-5f);
#pragma unroll
    for (int j = 0; j < 4; ++j) { const int c = 8 * (lane + 64 * j);
        const f32x4 o0 = v[2 * j] * rstd * *(const f32x4*)(g + c) + *(const f32x4*)(bb + c), o1 = v[2 * j + 1] * rstd * *(const f32x4*)(g + c + 4) + *(const f32x4*)(bb + c + 4);
        if (ob) { u32x4 w; w.x = pk2(o0[0], o0[1]); w.y = pk2(o0[2], o0[3]); w.z = pk2(o1[0], o1[1]); w.w = pk2(o1[2], o1[3]); *(u32x4*)(ob + c) = w; }
        else { __builtin_nontemporal_store(o0, (f32x4*)(of + c)); __builtin_nontemporal_store(o1, (f32x4*)(of + c + 4)); } }
}
__device__ __forceinline__ void ln_row(const float* zr, const float* g, const float* bb, bf16_t* ob, float* of, int lane) {
    f32x4 v[8]; float s = 0.f;
#pragma unroll
    for (int j = 0; j < 8; ++j) { v[j] = *(const f32x4*)(zr + 4 * (lane + 64 * j)); s += (v[j][0] + v[j][1]) + (v[j][2] + v[j][3]); }
    const float mean = wave_sum(s) * (1.f / DM); float s2 = 0.f;
#pragma unroll
    for (int j = 0; j < 8; ++j) { v[j] = v[j] - mean; s2 += (v[j][0] * v[j][0] + v[j][1] * v[j][1]) + (v[j][2] * v[j][2] + v[j][3] * v[j][3]); }
    const float rstd = 1.f / sqrtf(wave_sum(s2) * (1.f / DM) + 1e-5f);
#pragma unroll
    for (int j = 0; j < 8; ++j) { const int c = 4 * (lane + 64 * j); const f32x4 gg = *(const f32x4*)(g + c), b4 = *(const f32x4*)(bb + c);
        const f32x4 o = v[j] * rstd * gg + b4;
        if (ob) { u32x2 w; w.x = pk2(o[0], o[1]); w.y = pk2(o[2], o[3]); *(u32x2*)(ob + c) = w; } else *(f32x4*)(of + c) = o; }
}

__device__ __forceinline__ void attn_unit(LAS unsigned char* lds, const bf16_t* Q, const bf16_t* Kn, const bf16_t* Kr, const bf16_t* Vt, bf16_t* O, int b, int h, int qb, int wave_u) {
    int tid = wave_u * 64 + lane_id_v();
    const int wave = tid >> 6, lane = tid & 63, r = lane & 31, hh = lane >> 5;
    constexpr int ABUF = 44032;
    const bf16_t* qrow = Q + ((size_t)(b * 8 + h) * SEQ + qb * 256 + wave * 32 + r) * 192;
    bf16x8 qf[12];
#pragma unroll
    for (int ks = 0; ks < 12; ++ks) qf[ks] = *(const bf16x8*)(qrow + 16 * ks + 8 * hh);
    f32x16 oacc[4];
#pragma unroll
    for (int i = 0; i < 4; ++i)
#pragma unroll
        for (int j = 0; j < 16; ++j) oacc[i][j] = 0.f;
    float mrun = 0.f, lrun = 0.f;
    const bf16_t* Knb = Kn + (size_t)(b * 8 + h) * LK * 128; const bf16_t* Krb = Kr + (size_t)b * LK * 64; const bf16_t* Vtb = Vt + (size_t)(b * 8 + h) * 128 * LK;
    u32x4 pk[2], pr, pv[2];
    const int kc0 = tid, kc1 = tid + 512;
#define ATT_LOAD(kt) do { \
        pk[0] = *(const u32x4*)(Knb + (size_t)((kt) * 64 + (kc0 >> 4)) * 128 + (kc0 & 15) * 8); \
        pk[1] = *(const u32x4*)(Knb + (size_t)((kt) * 64 + (kc1 >> 4)) * 128 + (kc1 & 15) * 8); \
        pr = *(const u32x4*)(Krb + (size_t)((kt) * 64 + (tid >> 3)) * 64 + (tid & 7) * 8); \
        pv[0] = *(const u32x4*)(Vtb + (size_t)(kc0 >> 3) * LK + (kt) * 64 + (kc0 & 7) * 8); \
        pv[1] = *(const u32x4*)(Vtb + (size_t)(kc1 >> 3) * LK + (kt) * 64 + (kc1 & 7) * 8); } while (0)
#define ATT_STORE() do { \
        *(LAS u32x4*)(Ks + (kc0 >> 4) * 400 + (kc0 & 15) * 16) = pk[0]; \
        *(LAS u32x4*)(Ks + (kc1 >> 4) * 400 + (kc1 & 15) * 16) = pk[1]; \
        *(LAS u32x4*)(Ks + (tid >> 3) * 400 + 256 + (tid & 7) * 16) = pr; \
        *(LAS u32x4*)(Vs + (kc0 >> 3) * 144 + (kc0 & 7) * 16) = pv[0]; \
        *(LAS u32x4*)(Vs + (kc1 >> 3) * 144 + (kc1 & 7) * 16) = pv[1]; } while (0)
    ATT_LOAD(0);
    { LAS unsigned char* Ks = lds; LAS unsigned char* Vs = lds + 25600;
      ATT_STORE();
      ATT_LOAD(1); }
    for (int kt = 0; kt < 65; ++kt) {
        __syncthreads();
        LAS unsigned char* Ks = lds + (kt & 1) * ABUF; LAS unsigned char* Vs = Ks + 25600;
        f32x16 s0, s1;
        { const float negm = -mrun;
#pragma unroll
          for (int j = 0; j < 16; ++j) { s0[j] = negm; s1[j] = negm; } }
        {
            bf16x8 fa[3][4];
            const LAS unsigned char* k0p = Ks + r * 400 + hh * 16; const LAS unsigned char* k1p = k0p + 32 * 400;
#define ATT_RK(g, bf) do { fa[bf][0] = *(const LAS bf16x8*)(k0p + (2 * (g)) * 32); fa[bf][1] = *(const LAS bf16x8*)(k1p + (2 * (g)) * 32); \
                           fa[bf][2] = *(const LAS bf16x8*)(k0p + (2 * (g) + 1) * 32); fa[bf][3] = *(const LAS bf16x8*)(k1p + (2 * (g) + 1) * 32); } while (0)
            ATT_RK(0, 0); ATT_RK(1, 1);
            __builtin_amdgcn_sched_barrier(0);
            if (kt + 1 < 65) { LAS unsigned char* Ks = lds + ((kt + 1) & 1) * ABUF; LAS unsigned char* Vs = Ks + 25600; ATT_STORE(); }
            if (kt + 2 < 65) ATT_LOAD(kt + 2);
#pragma unroll
            for (int g = 0; g < 6; ++g) {
                if (g + 2 < 6) ATT_RK(g + 2, (g + 2) % 3);
                __builtin_amdgcn_sched_barrier(0);
                s0 = __builtin_amdgcn_mfma_f32_32x32x16_bf16(fa[g % 3][0], qf[2 * g], s0, 0, 0, 0);
                s1 = __builtin_amdgcn_mfma_f32_32x32x16_bf16(fa[g % 3][1], qf[2 * g], s1, 0, 0, 0);
                s0 = __builtin_amdgcn_mfma_f32_32x32x16_bf16(fa[g % 3][2], qf[2 * g + 1], s0, 0, 0, 0);
                s1 = __builtin_amdgcn_mfma_f32_32x32x16_bf16(fa[g % 3][3], qf[2 * g + 1], s1, 0, 0, 0);
                __builtin_amdgcn_sched_barrier(0);
            }
#undef ATT_RK
        }
        u32x4 fv[2][4];
        const LAS unsigned char* vbase = Vs + r * 144 + 16 * hh;
#define ATT_RV(kk, bf) do { _Pragma("unroll") for (int db = 0; db < 4; ++db) fv[bf][db] = *(const LAS u32x4*)(vbase + db * (32 * 144) + (kk) * 32); } while (0)
        ATT_RV(0, 0);
        if (kt == 64) {
#pragma unroll
            for (int j = 0; j < 16; ++j) { const int key = (j & 3) + 8 * (j >> 2) + 4 * hh;
                if (key >= 16) s0[j] = -1e30f; s1[j] = -1e30f; }
        }
        float mx = fmaxf(s0[0], s1[0]);
#pragma unroll
        for (int j = 1; j < 16; ++j) mx = fmaxf(mx, fmaxf(s0[j], s1[j]));
        mx = fmaxf(mx, shx(mx, lane, 32));
        if (__builtin_amdgcn_ballot_w64(fabsf(mx - (-28.0f)) > 36.0f) != 0ull) {
            const float shift = mx < -64.0f ? mx : fmaxf(mx, 0.f), alpha = __builtin_amdgcn_exp2f(-shift);
            mrun += shift; lrun *= alpha;
#pragma unroll
            for (int j = 0; j < 16; ++j) { s0[j] -= shift; s1[j] -= shift; }
#pragma unroll
            for (int i = 0; i < 4; ++i)
#pragma unroll
                for (int j = 0; j < 16; ++j) oacc[i][j] *= alpha;
        }
        { f32x2 ls2 = (f32x2){0.f, 0.f};
#pragma unroll
          for (int j = 0; j < 16; ++j) { s0[j] = __builtin_amdgcn_exp2f(s0[j]); s1[j] = __builtin_amdgcn_exp2f(s1[j]); ls2 += (f32x2){s0[j], s1[j]}; }
          lrun += ls2[0] + ls2[1]; }
        bf16x8 pf[4];
        { u32x4 t;
          t.x = cvtpk(s0[0], s0[1]); t.y = cvtpk(s0[2], s0[3]); t.z = cvtpk(s0[4], s0[5]); t.w = cvtpk(s0[6], s0[7]); pf[0] = __builtin_bit_cast(bf16x8, t);
          t.x = cvtpk(s0[8], s0[9]); t.y = cvtpk(s0[10], s0[11]); t.z = cvtpk(s0[12], s0[13]); t.w = cvtpk(s0[14], s0[15]); pf[1] = __builtin_bit_cast(bf16x8, t);
          t.x = cvtpk(s1[0], s1[1]); t.y = cvtpk(s1[2], s1[3]); t.z = cvtpk(s1[4], s1[5]); t.w = cvtpk(s1[6], s1[7]); pf[2] = __builtin_bit_cast(bf16x8, t);
          t.x = cvtpk(s1[8], s1[9]); t.y = cvtpk(s1[10], s1[11]); t.z = cvtpk(s1[12], s1[13]); t.w = cvtpk(s1[14], s1[15]); pf[3] = __builtin_bit_cast(bf16x8, t); }
        {
#pragma unroll
            for (int kk = 0; kk < 4; ++kk) {
                if (kk + 1 < 4) ATT_RV(kk + 1, (kk + 1) & 1);
                __builtin_amdgcn_sched_barrier(0);
#pragma unroll
                for (int db = 0; db < 4; ++db) oacc[db] = __builtin_amdgcn_mfma_f32_32x32x16_bf16(__builtin_bit_cast(bf16x8, fv[kk & 1][db]), pf[kk], oacc[db], 0, 0, 0);
                __builtin_amdgcn_sched_barrier(0);
            }
#undef ATT_RV
        }
    }
#undef ATT_LOAD
#undef ATT_STORE
    lrun += shx(lrun, lane, 32);
    const float inv = 1.f / lrun;
    bf16_t* orow = O + (size_t)(b * SEQ + qb * 256 + wave * 32 + r) * 1024 + h * 128;
#pragma unroll
    for (int db = 0; db < 4; ++db)
#pragma unroll
        for (int i4 = 0; i4 < 4; ++i4) { u32x2 w; w.x = pk2(oacc[db][4 * i4] * inv, oacc[db][4 * i4 + 1] * inv); w.y = pk2(oacc[db][4 * i4 + 2] * inv, oacc[db][4 * i4 + 3] * inv);
            *(u32x2*)(orow + 32 * db + 8 * i4 + 4 * hh) = w; }
}

__device__ __forceinline__ void ml_table_task(const float* gates, float* tab, int b, int h, int dir, int st, int lane) {
    const int l5 = lane & 31, tk = dir ? 31 - l5 : l5;
    const int rb = dir ? b * SEQ + (127 - st) * 32 : (st == 0 ? TR + b * 16 - 16 : b * SEQ + (st - 1) * 32);
    const bool valid = !(dir == 0 && st == 0 && tk < 16);
    float li = -1e30f, lf = 0.f;
    if (valid) { li = gates[(size_t)(rb + tk) * 16 + dir * 8 + h]; lf = gates[(size_t)(rb + tk) * 16 + dir * 8 + 4 + h]; }
    float bs = lf;
#pragma unroll
    for (int o = 1; o < 32; o <<= 1) { const float t = shl(bs, lane - o); if (l5 >= o) bs += t; }
    const float a = li - bs; float pm = a;
#pragma unroll
    for (int o = 1; o < 32; o <<= 1) { const float t = shl(pm, lane - o); if (l5 >= o) pm = fmaxf(pm, t); }
    float* T = tab + (size_t)st * 128;
    T[tk] = a; T[32 + tk] = pm; T[64 + tk] = bs;
    if (l5 == 31) { T[96] = bs; T[97] = pm; }
}
constexpr int MLB = 57344, ML_Q = 0, ML_K = 16384, ML_KT = 32768, ML_VT = 49152, ML_A = 114688, ML_SC = 117248;
__device__ __forceinline__ void dma16(const void* g, LAS unsigned char* l) { __builtin_amdgcn_global_load_lds((const unsigned*)g, (LAS unsigned*)l, 16, 0, 0); }
__device__ __forceinline__ void mlstm_unit(LAS unsigned char* lds, const bf16_t* mq, const bf16_t* mk, const bf16_t* mkT, const bf16_t* mvT, const float* gates, bf16_t* hout, float* tab, const void* zero16, int b, int h, int dir, int vh, int wave_u) {
    const int lane = lane_id_v(); const int tid = wave_u * 64 + lane;
    const int wave = wave_u;
    LAS float* SC = (LAS float*)(lds + ML_SC);
    LAS float* sa = SC; LAS float* spm = SC + 32; LAS float* sbb = SC + 64; LAS float* swt = SC + 96; LAS float* sei = SC + 128; LAS float* swc = SC + 160;
    LAS float* qnv = SC + 192; LAS float* rs = SC + 224; LAS float* nvec = SC + 288;
    const char* mqB = (const char*)(mq + (size_t)h * MR * 256); const char* mkB = (const char*)(mk + (size_t)h * MR * 256);
    const char* mkTB = (const char*)(mkT + (size_t)h * 256 * MR); const char* mvTB = (const char*)(mvT + ((size_t)h * 256 + vh * 128) * MR);
    const int nsteps = dir ? 128 : 129;
#define ML_RB(st) (dir ? b * SEQ + (127 - (st)) * 32 : ((st) == 0 ? TR + b * 16 - 16 : b * SEQ + ((st) - 1) * 32))
#define ML_META(st) (dir == 0 && (st) == 0)
    f32x4 Cacc[16];
#pragma unroll
    for (int i = 0; i < 16; ++i) Cacc[i] = (f32x4){0.f, 0.f, 0.f, 0.f};
    if (tid < 256) nvec[tid] = 0.f;
    __syncthreads();
#define ML_DMA(st, bf) do { const int rb_ = ML_RB(st); const bool meta_ = ML_META(st); LAS unsigned char* base_ = lds + (bf) * MLB; \
        _Pragma("unroll") for (int i = 0; i < 2; ++i) { const int q_ = wave * 2 + i, row = 2 * q_ + (lane_o >> 5), cs = (lane_o & 31) ^ (row & 15); \
            const bool ok = !meta_ || row >= 16; const size_t off = (size_t)(rb_ + row) * 512 + cs * 16; \
            dma16(ok ? (const void*)(mqB + off) : zero16, base_ + ML_Q + q_ * 1024); dma16(ok ? (const void*)(mkB + off) : zero16, base_ + ML_K + q_ * 1024); } \
        _Pragma("unroll") for (int i = 0; i < 2; ++i) { const int q_ = wave * 2 + i, d = 16 * q_ + (lane_o >> 2), cs = (lane_o & 3) ^ ((d >> 2) & 3); \
            const bool ok = !meta_ || cs >= 2; dma16(ok ? (const void*)(mkTB + ((size_t)d * MR + rb_ + cs * 8) * 2) : zero16, base_ + ML_KT + q_ * 1024); } \
        { const int q_ = wave, v = 16 * q_ + (lane_o >> 2), cs = (lane_o & 3) ^ ((v >> 2) & 3); \
            const bool ok = !meta_ || cs >= 2; dma16(ok ? (const void*)(mvTB + ((size_t)v * MR + rb_ + cs * 8) * 2) : zero16, base_ + ML_VT + q_ * 1024); } } while (0)
    float mstate = 0.f;
    float bL = tab[96], amax = tab[97];
    if (tid < 32) { sa[tid] = tab[tid]; spm[tid] = tab[32 + tid]; sbb[tid] = tab[64 + tid]; }
    { const int lane_o = lane; ML_DMA(0, 0); }
    asm volatile("s_waitcnt vmcnt(0)" ::: "memory");
    __syncthreads();
    for (int st = 0; st < nsteps; ++st) {
        const int lane_o = lane;
        const int frl = lane_o & 15, fql = lane_o >> 4, tidl = wave * 64 + lane_o;
        const int cur = st & 1; LAS unsigned char* B_ = lds + cur * MLB;
        float na = 0.f, npm = 0.f, nbb = 0.f, nbL = 0.f, namax = 0.f;
        if (st + 1 < nsteps) { const float* Tn = tab + (size_t)(st + 1) * 128; nbL = Tn[96]; namax = Tn[97]; if (tidl < 32) { na = Tn[tidl]; npm = Tn[32 + tidl]; nbb = Tn[64 + tidl]; } }
        asm volatile("" ::: "memory");
        if (st + 1 < nsteps) ML_DMA(st + 1, cur ^ 1);
        const float mrel = fmaxf(mstate, amax), decay = __expf(mstate - mrel);
        if (tidl < 32) { const float Mt = fmaxf(mstate, spm[tidl]); swt[tidl] = __expf(mstate - Mt); sei[tidl] = __expf(-(sbb[tidl] + Mt)); swc[tidl] = __expf(sa[tidl] - mrel); }
        if (wave < 4) { const int si = wave >> 1, tj = wave & 1;
            const bool skip = dir ? (si < tj) : (si > tj);
            f32x4 acc = (f32x4){0.f, 0.f, 0.f, 0.f};
            if (!skip) {
#pragma unroll
                for (int kk = 0; kk < 8; ++kk) { const int cs = ((4 * kk + fql) ^ frl) * 16;
                    const bf16x8 a = *(const LAS bf16x8*)(B_ + ML_K + (16 * si + frl) * 512 + cs);
                    const bf16x8 bq = *(const LAS bf16x8*)(B_ + ML_Q + (16 * tj + frl) * 512 + cs);
                    acc = __builtin_amdgcn_mfma_f32_16x16x32_bf16(a, bq, acc, 0, 0, 0);
                }
            }
            const int t = 16 * tj + frl; const float Mt = fmaxf(mstate, spm[t]); float ps = 0.f; float o[4];
            const f32x4 sa4 = *(const LAS f32x4*)(sa + 16 * si + 4 * fql);
#pragma unroll
            for (int j = 0; j < 4; ++j) { const int s_ = 16 * si + 4 * fql + j; const bool ok = !skip && (dir ? (s_ >= t) : (s_ <= t));
                o[j] = ok ? __expf(sa4[j] - Mt) * acc[j] : 0.f; ps += o[j]; }
            u32x2 w; w.x = cvtpk(o[0], o[1]); w.y = cvtpk(o[2], o[3]);
            *(LAS u32x2*)(lds + ML_A + t * 80 + (16 * si + 4 * fql) * 2) = w;
            ps += shx(ps, lane_o, 16); ps += shx(ps, lane_o, 32);
            if (fql == 0) rs[si * 32 + t] = ps; }
        if (wave >= 4) { const int t2 = (tidl - 256) >> 3, part = tidl & 7; float dsum = 0.f;
#pragma unroll
          for (int i = 0; i < 4; ++i) { const u32x4 qv = *(const LAS u32x4*)(B_ + ML_Q + t2 * 512 + (((4 * part + i) ^ (t2 & 15)) * 16)); const LAS float* nn = nvec + part * 32 + i * 8;
              dsum += bflo(qv.x) * nn[0] + bfhi(qv.x) * nn[1] + bflo(qv.y) * nn[2] + bfhi(qv.y) * nn[3] + bflo(qv.z) * nn[4] + bfhi(qv.z) * nn[5] + bflo(qv.w) * nn[6] + bfhi(qv.w) * nn[7]; }
          dsum += shx(dsum, lane_o, 1); dsum += shx(dsum, lane_o, 2); dsum += shx(dsum, lane_o, 4);
          if (part == 0) qnv[t2] = dsum; }
        f32x4 num[2];
#pragma unroll
        for (int ti = 0; ti < 2; ++ti) num[ti] = (f32x4){0.f, 0.f, 0.f, 0.f};
#pragma unroll
        for (int i = 0; i < 8; ++i) {
            u32x4 cb; cb.x = cvtpk(Cacc[2 * i][0], Cacc[2 * i][1]); cb.y = cvtpk(Cacc[2 * i][2], Cacc[2 * i][3]); cb.z = cvtpk(Cacc[2 * i + 1][0], Cacc[2 * i + 1][1]); cb.w = cvtpk(Cacc[2 * i + 1][2], Cacc[2 * i + 1][3]);
            const bf16x8 bfr = __builtin_bit_cast(bf16x8, cb);
            const int c0s = ((4 * i + fql) ^ frl) * 16;
#pragma unroll
            for (int ti = 0; ti < 2; ++ti) {
                const bf16x8 qa = *(const LAS bf16x8*)(B_ + ML_Q + (16 * ti + frl) * 512 + c0s);
                num[ti] = __builtin_amdgcn_mfma_f32_16x16x32_bf16(qa, bfr, num[ti], 0, 0, 0);
            }
        }
        asm volatile("s_waitcnt lgkmcnt(0)" ::: "memory");
        __builtin_amdgcn_s_barrier();
        asm volatile("" ::: "memory");
        bf16x8 vfr, vfw;
        { const int v = 16 * wave + frl;
            const u32x4 raw = *(const LAS u32x4*)(B_ + ML_VT + v * 64 + ((fql ^ ((v >> 2) & 3)) * 16));
            vfr = __builtin_bit_cast(bf16x8, raw);
            const LAS float* w = swc + 8 * fql; u32x4 sc;
            sc.x = cvtpk(bflo(raw.x) * w[0], bfhi(raw.x) * w[1]); sc.y = cvtpk(bflo(raw.y) * w[2], bfhi(raw.y) * w[3]); sc.z = cvtpk(bflo(raw.z) * w[4], bfhi(raw.z) * w[5]); sc.w = cvtpk(bflo(raw.w) * w[6], bfhi(raw.w) * w[7]);
            vfw = __builtin_bit_cast(bf16x8, sc); }
#pragma unroll
        for (int ti = 0; ti < 2; ++ti) {
            num[ti] = num[ti] * *(const LAS f32x4*)(swt + 16 * ti + 4 * fql);
            const bf16x8 a = *(const LAS bf16x8*)(lds + ML_A + (16 * ti + frl) * 80 + fql * 16);
            num[ti] = __builtin_amdgcn_mfma_f32_16x16x32_bf16(a, vfr, num[ti], 0, 0, 0);
        }
        if (!ML_META(st)) { bf16_t* hb_ = hout + (size_t)ML_RB(st) * 1024 + h * 256 + vh * 128 + 16 * wave;
#pragma unroll
            for (int ti = 0; ti < 2; ++ti) { const int t0 = 16 * ti + 4 * fql;
                const f32x4 den = *(const LAS f32x4*)(rs + t0) + *(const LAS f32x4*)(rs + 32 + t0) + *(const LAS f32x4*)(swt + t0) * *(const LAS f32x4*)(qnv + t0);
                const f32x4 fl = *(const LAS f32x4*)(sei + t0);
#pragma unroll
                for (int j = 0; j < 4; ++j) { const float hv = num[ti][j] * __builtin_amdgcn_rcpf(fmaxf(fabsf(den[j]), fl[j]));
                    hb_[(unsigned)((t0 + j) * 1024 + frl)] = (bf16_t)(cvtpk(hv, 0.f) & 0xffffu); } }
        }
#pragma unroll
        for (int dt = 0; dt < 16; ++dt) { const int d = 16 * dt + frl;
            Cacc[dt] = Cacc[dt] * decay;
            const bf16x8 a = *(const LAS bf16x8*)(B_ + ML_KT + d * 64 + ((fql ^ ((d >> 2) & 3)) * 16));
            Cacc[dt] = __builtin_amdgcn_mfma_f32_16x16x32_bf16(a, vfw, Cacc[dt], 0, 0, 0);
        }
        if (tidl < 256) { float sum = 0.f;
#pragma unroll
            for (int i = 0; i < 4; ++i) { const u32x4 kv = *(const LAS u32x4*)(B_ + ML_KT + tidl * 64 + ((i ^ ((tidl >> 2) & 3)) * 16)); const LAS float* w = swc + 8 * i;
                sum += bflo(kv.x) * w[0] + bfhi(kv.x) * w[1] + bflo(kv.y) * w[2] + bfhi(kv.y) * w[3] + bflo(kv.z) * w[4] + bfhi(kv.z) * w[5] + bflo(kv.w) * w[6] + bfhi(kv.w) * w[7]; }
            const int pd = (tidl & ~31) | perm_qk(tidl & 31);
            nvec[pd] = decay * nvec[pd] + sum; }
        asm volatile("s_waitcnt vmcnt(0)" ::: "memory");
        mstate = bL + mrel; bL = nbL; amax = namax;
        if (st + 1 < nsteps && tidl < 32) { sa[tidl] = na; spm[tidl] = npm; sbb[tidl] = nbb; }
        __syncthreads();
    }
#undef ML_DMA
#undef ML_RB
#undef ML_META
}

__device__ __forceinline__ f32x4 skinny16(const bf16_t* A, int lda, const bf16_t* Bt, int ldb, int K, int fr, int fq) {
    f32x4 acc0 = (f32x4){0.f, 0.f, 0.f, 0.f}, acc1 = (f32x4){0.f, 0.f, 0.f, 0.f};
    const bf16_t* ap = A + (size_t)fr * lda + 8 * fq; const bf16_t* bp = Bt + (size_t)fr * ldb + 8 * fq;
#pragma unroll 4
    for (int k = 0; k < K; k += 64) {
        const bf16x8 a0 = *(const bf16x8*)(ap + k), b0 = *(const bf16x8*)(bp + k), a1 = *(const bf16x8*)(ap + k + 32), b1 = *(const bf16x8*)(bp + k + 32);
        acc0 = __builtin_amdgcn_mfma_f32_16x16x32_bf16(a0, b0, acc0, 0, 0, 0);
        acc1 = __builtin_amdgcn_mfma_f32_16x16x32_bf16(a1, b1, acc1, 0, 0, 0);
    }
    return acc0 + acc1;
}

#define XB_TMO      128
#define XB_XCNT(j)  (256  + 64 * (j))
#define XB_XSUB(j)  (1280 + 64 * (j))
#define XB_XGEN(j)  (2304 + 64 * (j))
#define XB_TOP      3328
#define XB_TOPGEN   3392
#define XCD_BAR_WORDS 3456
#define XB_SPIN_CAP (1u << 18)

__device__ __forceinline__ unsigned xb_ld(unsigned* p)              { return __hip_atomic_load(p, __ATOMIC_RELAXED, __HIP_MEMORY_SCOPE_AGENT); }
__device__ __forceinline__ unsigned xb_add(unsigned* p, unsigned v) { return __hip_atomic_fetch_add(p, v, __ATOMIC_RELAXED, __HIP_MEMORY_SCOPE_AGENT); }
__device__ __forceinline__ unsigned xb_xcc_id() { return (unsigned)__builtin_amdgcn_s_getreg((3 << 11) | 20) & 0xFu; }
#define XB_SPIN(cond, bar) do { unsigned _sp = 0; while (cond) { __builtin_amdgcn_s_sleep(1); \
    if ((++_sp & 255u) == 0u) { if (xb_ld(&(bar)[XB_TMO])) break; if (_sp > XB_SPIN_CAP) { atomicAdd(&(bar)[XB_TMO], 1u); break; } } } } while (0)

struct XcdBarrier {
    unsigned* bar; unsigned x;
    volatile LAS unsigned* st;
};

__device__ __forceinline__ XcdBarrier xcd_barrier_post(unsigned* bar, volatile LAS unsigned* st) {
    XcdBarrier b; b.bar = bar; b.x = xb_xcc_id(); b.st = st;
    if (threadIdx.x == 0) (void)xb_add(&bar[XB_XCNT(b.x)], 1u);
    return b;
}
__device__ __forceinline__ void xcd_barrier_complete(unsigned* bar, unsigned x, unsigned& nloc, unsigned& nx) {
    const unsigned G = gridDim.x * gridDim.y * gridDim.z;
    unsigned sum, cnt, mine, sp = 0u;
    for (;;) {
        sum = 0u; cnt = 0u; mine = 0u;
#pragma unroll
        for (unsigned j = 0; j < 16; ++j) { const unsigned c = xb_ld(&bar[XB_XCNT(j)]); sum += c; cnt += (c > 0u) ? 1u : 0u; mine = (j == x) ? c : mine; }
        if (sum == G) break;
        __builtin_amdgcn_s_sleep(1);
        if ((++sp & 255u) == 0u) { if (xb_ld(&bar[XB_TMO])) break; if (sp > XB_SPIN_CAP) { atomicAdd(&bar[XB_TMO], 1u); break; } }
    }
    nloc = mine > 0u ? mine : 1u; nx = cnt > 0u ? cnt : 1u;
}

__device__ __forceinline__ void xcd_barrier(const XcdBarrier& b) {
    asm volatile("s_waitcnt vmcnt(0)" ::: "memory");
    __syncthreads();
    if (threadIdx.x == 0) {
        unsigned* bar = b.bar;
        __builtin_amdgcn_s_waitcnt(0);
        unsigned nloc = b.st[0], nx = b.st[1];
        if (nloc == 0u) { xcd_barrier_complete(bar, b.x, nloc, nx); b.st[0] = nloc; b.st[1] = nx; }
        const unsigned old = xb_add(&bar[XB_XSUB(b.x)], 1u);
        const unsigned gen = old / nloc;
        if (old + 1u == (gen + 1u) * nloc) {
            __builtin_amdgcn_fence(__ATOMIC_RELEASE, "agent");
            asm volatile("s_waitcnt vmcnt(0)" ::: "memory");
            const unsigned og = xb_add(&bar[XB_TOP], 1u);
            const unsigned tg = og / nx;
            if (og + 1u == (tg + 1u) * nx) xb_add(&bar[XB_TOPGEN], 1u);
            else XB_SPIN(xb_ld(&bar[XB_TOPGEN]) == tg, bar);
            __builtin_amdgcn_fence(__ATOMIC_ACQUIRE, "agent");
            xb_add(&bar[XB_XGEN(b.x)], 1u);
            asm volatile("s_waitcnt vmcnt(0)" ::: "memory");
        } else {
            XB_SPIN(xb_ld(&bar[XB_XGEN(b.x)]) == gen, bar);
            __builtin_amdgcn_fence(__ATOMIC_ACQUIRE, "agent");
            asm volatile("s_waitcnt vmcnt(0)" ::: "memory");
        }
    }
    __syncthreads();
}

__global__ void __launch_bounds__(NTHR, 2) fwd_mega(Args args) {
    extern __shared__ __attribute__((aligned(16))) unsigned char lds_raw[];
    LAS unsigned char* lds = (LAS unsigned char*)lds_raw;
    cg::grid_group grid = cg::this_grid();
    const int G = gridDim.x;
    if (threadIdx.x < 2) ((volatile LAS unsigned*)(lds + 140016))[threadIdx.x] = 0u;
    __syncthreads();
    XcdBarrier xbar = xcd_barrier_post((unsigned*)(args.wsp + WS_BAR), (volatile LAS unsigned*)(lds + 140016));
    if (gridDim.x == 0x7fffffffu) grid.sync();
    const int wave_u = __builtin_amdgcn_readfirstlane((int)(threadIdx.x >> 6));
#define PHASE_VARS int tid = wave_u * 64 + lane_id_v(); const int lane = tid & 63, wave = tid >> 6, gw = blockIdx.x * 8 + wave, NGW = G * 8; LAS float* scr = (LAS float*)(lds + wave * 16384); (void)lane; (void)gw; (void)NGW; (void)scr;
#define ws (args.wsp)
#define ctl ((unsigned*)(args.wsp + WS_CTL))
#define rope ((f32x2*)(args.wsp + WS_ROPE))
#define zmeta ((float*)(args.wsp + WS_ZMETA))
#define h0 ((bf16_t*)(args.wsp + WS_H0))
#define h1 ((bf16_t*)(args.wsp + WS_H1))
#define h2 ((bf16_t*)(args.wsp + WS_H2))
#define Gb ((bf16_t*)(args.wsp + WS_G))
#define ub ((bf16_t*)(args.wsp + WS_U))
#define qn ((bf16_t*)(args.wsp + WS_QN))
#define kvn ((bf16_t*)(args.wsp + WS_KVN))
#define xc ((bf16_t*)(args.wsp + WS_XC))
#define gates ((float*)(args.wsp + WS_GATES))
#define Kn ((bf16_t*)(args.wsp + WS_KN))
#define Vt ((bf16_t*)(args.wsp + WS_VT))
#define Kr ((bf16_t*)(args.wsp + WS_KROPE))
#define oatt ((bf16_t*)(args.wsp + WS_OATT))
#define mkT ((bf16_t*)(args.wsp + WS_MKT))
#define mq ((bf16_t*)(args.wsp + WS_MQ))
#define mk ((bf16_t*)(args.wsp + WS_MK))
#define mvT ((bf16_t*)(args.wsp + WS_MVT))
#define ycat ((bf16_t*)(args.wsp + WS_YCAT))
#define Qb ((bf16_t*)((unsigned char*)args.out + DO_Q))
#define hf ((bf16_t*)((unsigned char*)args.out + DO_HF))
#define hb ((bf16_t*)((unsigned char*)args.out + DO_HB))

    {
        PHASE_VARS
        ffn_weights(args.in[I_F1G], args.in[I_F1U], args.in[I_F1D], ws, scr, gw, NGW, lane);
        constexpr int N_WIN = 32 * 90, N_WUQ = 8 * 48, N_WKV = 4 * 64, N_M = 3 * 4 * 4 * 8, N_WOUT = 32 * 64;
        for (int it = gw; it < N_WIN + N_WUQ + N_WKV + N_M + N_WOUT; it += NGW) {
            int r = it;
            if (r < N_WIN) { const int kb = r / 90, nb = r % 90; tr_item(args.in[I_WIN], 2880, (bf16_t*)(ws + WS_WIN), DM, nb * 32, kb * 64, nb * 32, scr, lane, 1.f); continue; } r -= N_WIN;
            if (r < N_WUQ) { const int kb = r / 48, nb = r % 48, n0 = nb * 32, hq = n0 / 192, d0 = n0 % 192; int dst;
                if (d0 < 128) dst = hq * 128 + d0; else { const int p = hq * 32; dst = 1024 + (p >> 7) * 256 + (d0 >= 160 ? 128 : 0) + (p & 127); }
                tr_item(args.in[I_WUQ], 1536, (bf16_t*)(ws + WS_WUQ), 512, dst, kb * 64, n0, scr, lane, 1.f); continue; } r -= N_WUQ;
            if (r < N_WKV) { const int kb = r / 64, nb = r % 64, n0 = nb * 32, hk = n0 >> 8, c0 = n0 & 255;
                if (c0 < 128) tr_item(args.in[I_WUKV], 2048, (bf16_t*)(ws + WS_WK), 256, hk * 128 + c0, kb * 64, n0, scr, lane, 1.f);
                else tr_item(args.in[I_WUKV], 2048, (bf16_t*)(ws + WS_WV), 256, hk * 128 + c0 - 128, kb * 64, n0, scr, lane, 1.f);
                continue; } r -= N_WKV;
            if (r < N_M) { const int mat = r / 128, hm = (r % 128) / 32, q = r % 32, kb = q / 8, nb = q % 8;
                const float* src = args.in[I_MWQ + mat] + (size_t)hm * 65536;
                bf16_t* dst = (bf16_t*)(ws + (mat == 0 ? WS_WMQ : mat == 1 ? WS_WMK : WS_WMV)) + (size_t)hm * 65536;
                tr_item(src, 256, dst, 256, nb * 32, kb * 64, nb * 32, scr, lane, mat == 1 ? 0.0625f : 1.f, mat < 2);
                if (mat == 1) tr_item(src, 256, (bf16_t*)(ws + WS_WMKN) + (size_t)hm * 65536, 256, nb * 32, kb * 64, nb * 32, scr, lane, 0.0625f);
                continue; } r -= N_M;
            { const int kb = r / 64, nb = r % 64; tr_item(args.in[I_WOUT], DM, (bf16_t*)(ws + WS_WOUT), DM, nb * 32, kb * 64, nb * 32, scr, lane, 1.f); }
        }
        for (int row = gw; row < MR; row += NGW) {
            const float* src = row < TR ? args.in[I_X] + (size_t)row * DM : (row < MROWS ? args.in[I_META] + (size_t)((row - TR) & 15) * DM : nullptr);
#pragma unroll
            for (int j = 0; j < 4; ++j) { const int c = 8 * (lane + 64 * j); u32x4 w = (u32x4){0, 0, 0, 0};
                if (src) { const f32x4 a = __builtin_nontemporal_load((const f32x4*)(src + c)), bq = __builtin_nontemporal_load((const f32x4*)(src + c + 4)); w.x = pk2(a[0], a[1]); w.y = pk2(a[2], a[3]); w.z = pk2(bq[0], bq[1]); w.w = pk2(bq[2], bq[3]); }
                *(u32x4*)(h0 + (size_t)row * DM + c) = w; }
        }
        for (int i = blockIdx.x * NTHR + tid; i < 16 * 2048; i += G * NTHR) { const int gi = i >> 11, k = i & 2047; ((bf16_t*)(ws + WS_WGT))[i] = (bf16_t)f2bf(args.in[I_WG][(size_t)k * 16 + gi]); }
        for (int i = blockIdx.x * NTHR + tid; i < LTOT * 32; i += G * NTHR) { const int pos = i >> 5, k = i & 31;
            const float inv = powf(10000.f, -(float)(2 * k) / 64.f), ang = (float)pos * inv; rope[i] = (f32x2){cosf(ang), sinf(ang)}; }
    }
    xcd_barrier(xbar);
    { pg8::Gemm g{DM, DM, DM}; pg8::Sched S; S.init(TR / 256, 44, 1, G, blockIdx.x, h0, ws + WS_WGU, 0, 0, 1, DM, DM);
      pg8::EpiSwiGLU E{Gb}; pg8::gemm_phase<GEMM_SP2, GEMM_ALIGN>(lds, g, S, E, wave_u); }
    { PHASE_VARS const int fr = lane & 15, fq = lane >> 4; LAS float* red = (LAS float*)lds;
      for (int bu = blockIdx.x; bu < FF / 16; bu += G) { const int f0 = bu * 16, r0 = (f0 >> 7) * 256 + (f0 & 127), k0 = wave * (DM / 8);
          const f32x4 ag = skinny16(h0 + (size_t)TR * DM + k0, DM, (const bf16_t*)(ws + WS_WGU) + (size_t)r0 * DM + k0, DM, DM / 8, fr, fq);
          const f32x4 au = skinny16(h0 + (size_t)TR * DM + k0, DM, (const bf16_t*)(ws + WS_WGU) + (size_t)(r0 + 128) * DM + k0, DM, DM / 8, fr, fq);
#pragma unroll
          for (int j = 0; j < 4; ++j) { red[(wave * 16 + 4 * fq + j) * 16 + fr] = ag[j]; red[2048 + (wave * 16 + 4 * fq + j) * 16 + fr] = au[j]; }
          __syncthreads();
          if (tid < 256) { float g = 0.f, u = 0.f;
#pragma unroll
              for (int w = 0; w < 8; ++w) { g += red[w * 256 + tid]; u += red[2048 + w * 256 + tid]; }
              Gb[(size_t)(TR + (tid >> 4)) * FF + f0 + (tid & 15)] = (bf16_t)f2bf(siluf(g) * u); }
          __syncthreads(); } }
    xcd_barrier(xbar);
    { pg8::Gemm g{FF, FF, FF}; pg8::Sched S; S.init(TR / 256, 8, 1, G, blockIdx.x, Gb, ws + WS_WD, 0, 0, 1, FF, FF);
      pg8::EpiResid E{h0, (bf16_t*)(ws + WS_RM), 0.5f}; pg8::gemm_phase<GEMM_SP2, GEMM_ALIGN>(lds, g, S, E, wave_u); }
    { PHASE_VARS const int fr = lane & 15, fq = lane >> 4; LAS float* red = (LAS float*)lds;
      for (int bu = blockIdx.x; bu < DM / 16; bu += G) { const int c0 = bu * 16, k0 = wave * (FF / 8);
          const f32x4 a = skinny16(Gb + (size_t)TR * FF + k0, FF, (const bf16_t*)(ws + WS_WD) + (size_t)c0 * FF + k0, FF, FF / 8, fr, fq);
#pragma unroll
          for (int j = 0; j < 4; ++j) red[(wave * 16 + 4 * fq + j) * 16 + fr] = a[j];
          __syncthreads();
          if (tid < 256) { float v = 0.f;
#pragma unroll
              for (int w = 0; w < 8; ++w) v += red[w * 256 + tid];
              const int m = tid >> 4, c = c0 + (tid & 15); v = ALPHA * bf1(h0[(size_t)(TR + m) * DM + c]) + 0.5f * v;
#pragma unroll
              for (int bb = 0; bb < 4; ++bb) zmeta[(size_t)(bb * 16 + m) * DM + c] = v; }
          __syncthreads(); } }
    xcd_barrier(xbar);
    { PHASE_VARS
    for (int row = gw; row < MROWS; row += NGW) {
        if (row < TR) ln_row_b((const bf16_t*)(ws + WS_RM) + (size_t)row * DM, args.in[I_LN1G], args.in[I_LN1B], h1 + (size_t)row * DM, nullptr, lane);
        else ln_row(zmeta + (size_t)(row - TR) * DM, args.in[I_LN1G], args.in[I_LN1B], h1 + (size_t)row * DM, nullptr, lane); } }
    xcd_barrier(xbar);
    { pg8::Gemm g{DM, DM, DM}; pg8::Sched S; S.init(TR / 256, 12, 1, G, blockIdx.x, h1, ws + WS_WIN, 0, 0, 1, DM, DM);
      pg8::EpiBf16 E{ub, UW, 0, 1 << 30, 1.f}; pg8::gemm_phase<GEMM_SP2, GEMM_ALIGN>(lds, g, S, E, wave_u); }
    { PHASE_VARS const int fr = lane & 15, fq = lane >> 4; LAS float* red = (LAS float*)lds;
      for (int bu = blockIdx.x; bu < 2880 / 16; bu += G) { const int c0 = bu * 16, k0 = wave * (DM / 8);
          const f32x4 a = skinny16(h1 + (size_t)TR * DM + k0, DM, (const bf16_t*)(ws + WS_WIN) + (size_t)c0 * DM + k0, DM, DM / 8, fr, fq);
#pragma unroll
          for (int j = 0; j < 4; ++j) red[(wave * 16 + 4 * fq + j) * 16 + fr] = a[j];
          __syncthreads();
          if (tid < 256) { float v = 0.f;
#pragma unroll
              for (int w = 0; w < 8; ++w) v += red[w * 256 + tid];
              const int m = tid >> 4, c = c0 + (tid & 15); const bf16_t o = (bf16_t)f2bf(v);
#pragma unroll
              for (int bb = 0; bb < 4; ++bb) ub[(size_t)(TR + bb * 16 + m) * UW + c] = o; }
          __syncthreads(); } }
    xcd_barrier(xbar);
    {
        PHASE_VARS
        const float* cw = args.in[I_CW]; const float* cb = args.in[I_CB];
        for (int row = gw; row < MROWS; row += NGW) {
            int b, pos, key; if (row < TR) { b = row >> 12; key = row & 4095; pos = 16 + key; } else { b = (row - TR) >> 4; pos = (row - TR) & 15; key = SEQ + pos; }
            const bf16_t* ur = ub + (size_t)row * UW;
            { const u32x4 v = *(const u32x4*)(ur + 8 * lane); float f[8] = {bflo(v.x), bfhi(v.x), bflo(v.y), bfhi(v.y), bflo(v.z), bfhi(v.z), bflo(v.w), bfhi(v.w)};
              float ss = 0.f;
#pragma unroll
              for (int i = 0; i < 8; ++i) ss += f[i] * f[i];
              const float rms = 1.f / sqrtf(wave_sum(ss) * (1.f / 512.f) + 1e-6f); const float* gq = args.in[I_QNG] + 8 * lane;
              u32x4 w; w.x = pk2(f[0] * rms * gq[0], f[1] * rms * gq[1]); w.y = pk2(f[2] * rms * gq[2], f[3] * rms * gq[3]); w.z = pk2(f[4] * rms * gq[4], f[5] * rms * gq[5]); w.w = pk2(f[6] * rms * gq[6], f[7] * rms * gq[7]);
              *(u32x4*)(qn + (size_t)row * 512 + 8 * lane) = w; }
            { const u32x2 v = *(const u32x2*)(ur + O2 + 4 * lane); float f[4] = {bflo(v.x), bfhi(v.x), bflo(v.y), bfhi(v.y)};
              const float ss = f[0] * f[0] + f[1] * f[1] + f[2] * f[2] + f[3] * f[3];
              const float rms = 1.f / sqrtf(wave_sum(ss) * (1.f / 256.f) + 1e-6f); const float* gk = args.in[I_KVNG] + 4 * lane;
              u32x2 w; w.x = pk2(f[0] * rms * gk[0], f[1] * rms * gk[1]); w.y = pk2(f[2] * rms * gk[2], f[3] * rms * gk[3]);
              *(u32x2*)(kvn + (size_t)row * 256 + 4 * lane) = w; }
            if (lane < 32) { const float x1 = bf1(ur[O3 + lane]), x2 = bf1(ur[O3 + 32 + lane]); const f32x2 cs = rope[pos * 32 + lane];
              bf16_t* kp = Kr + ((size_t)b * LK + key) * 64; kp[lane] = (bf16_t)f2bf(x1 * cs.x - x2 * cs.y); kp[32 + lane] = (bf16_t)f2bf(x2 * cs.x + x1 * cs.y); }
            { float acc[16];
#pragma unroll
              for (int i = 0; i < 16; ++i) acc[i] = cb[16 * lane + i];
#pragma unroll
              for (int t = 0; t < 5; ++t) { const int q = pos - 2 + t;
                  if (q >= 0 && q < LTOT) { const int nr = q < 16 ? TR + b * 16 + q : b * SEQ + q - 16; const bf16_t* xr = ub + (size_t)nr * UW + O4 + 16 * lane;
                      const u32x4 v0 = *(const u32x4*)xr, v1 = *(const u32x4*)(xr + 8); const float* wt = cw + t * 1024 + 16 * lane;
                      acc[0] += wt[0] * bflo(v0.x); acc[1] += wt[1] * bfhi(v0.x); acc[2] += wt[2] * bflo(v0.y); acc[3] += wt[3] * bfhi(v0.y);
                      acc[4] += wt[4] * bflo(v0.z); acc[5] += wt[5] * bfhi(v0.z); acc[6] += wt[6] * bflo(v0.w); acc[7] += wt[7] * bfhi(v0.w);
                      acc[8] += wt[8] * bflo(v1.x); acc[9] += wt[9] * bfhi(v1.x); acc[10] += wt[10] * bflo(v1.y); acc[11] += wt[11] * bfhi(v1.y);
                      acc[12] += wt[12] * bflo(v1.z); acc[13] += wt[13] * bfhi(v1.z); acc[14] += wt[14] * bflo(v1.w); acc[15] += wt[15] * bfhi(v1.w); } }
              u32x4 w0, w1;
              w0.x = pk2(siluf(acc[0]), siluf(acc[1])); w0.y = pk2(siluf(acc[2]), siluf(acc[3])); w0.z = pk2(siluf(acc[4]), siluf(acc[5])); w0.w = pk2(siluf(acc[6]), siluf(acc[7]));
              w1.x = pk2(siluf(acc[8]), siluf(acc[9])); w1.y = pk2(siluf(acc[10]), siluf(acc[11])); w1.z = pk2(siluf(acc[12]), siluf(acc[13])); w1.w = pk2(siluf(acc[14]), siluf(acc[15]));
              *(u32x4*)(xc + (size_t)row * 1024 + 16 * lane) = w0; *(u32x4*)(xc + (size_t)row * 1024 + 16 * lane + 8) = w1; }
        }
        for (int i = blockIdx.x * NTHR + tid; i < 32 * 48 * 128; i += G * NTHR) { const int bh = i / (48 * 128), rem = i % (48 * 128); Kn[((size_t)bh * LK + LTOT) * 128 + rem] = 0; }
        for (int i = blockIdx.x * NTHR + tid; i < 4 * 48 * 64; i += G * NTHR) { const int bb = i / (48 * 64), rem = i % (48 * 64); Kr[((size_t)bb * LK + LTOT) * 64 + rem] = 0; }
        for (int i = blockIdx.x * NTHR + tid; i < 32 * 128 * 48; i += G * NTHR) { const int bhd = i / 48, rem = i % 48; Vt[(size_t)bhd * LK + LTOT + rem] = 0; }
    }
    xcd_barrier(xbar);
    { PHASE_VARS const int fr = lane & 15, fq = lane >> 4; const bf16_t* WgT = (const bf16_t*)(ws + WS_WGT); LAS float* red = (LAS float*)lds;
      for (int bu = blockIdx.x; bu < MROWS / 16; bu += G) { const int r0 = bu * 16;
          const f32x4 a = wave < 4 ? skinny16(xc + (size_t)r0 * 1024 + wave * 256, 1024, WgT + wave * 256, 2048, 256, fr, fq)
                                   : skinny16(ub + (size_t)r0 * UW + O4 + (wave - 4) * 256, UW, WgT + wave * 256, 2048, 256, fr, fq);
#pragma unroll
          for (int j = 0; j < 4; ++j) red[(wave * 16 + 4 * fq + j) * 16 + fr] = a[j];
          __syncthreads();
          if (tid < 256) { float sv = args.in[I_BG][tid & 15];
#pragma unroll
              for (int w = 0; w < 8; ++w) sv += red[w * 256 + tid];
              if (((tid & 15) >> 2) & 1) sv = fminf(sv, 0.f) - log1pf(__expf(-fabsf(sv)));
              gates[(size_t)(r0 + (tid >> 4)) * 16 + (tid & 15)] = sv; }
          __syncthreads(); } }
    xcd_barrier(xbar);
    { PHASE_VARS
      for (int task = gw * 2 + (lane >> 5); task < 32 * 129; task += NGW * 2) { const int sq = task / 129, st = task - sq * 129, dir = sq & 1;
          if (st < (dir ? 128 : 129)) ml_table_task(gates, (float*)(ws + WS_TAB) + (size_t)sq * 129 * 128, sq >> 3, (sq >> 1) & 3, dir, st, lane); } }
    { pg8::Gemm g{512, 512, 512}; pg8::Sched S; S.init(TR / 256, 6, 1, G, blockIdx.x, qn, ws + WS_WUQ, 0, 0, 1, 512, 512);
      pg8::EpiQ E{Qb, rope}; pg8::gemm_phase<false, GEMM_ALIGN>(lds, g, S, E, wave_u); }
    { pg8::Gemm g{256, 256, 256}; pg8::Sched S; S.init(MR / 256, 4, 1, G, (blockIdx.x + 128) % G, kvn, ws + WS_WK, 0, 0, 1, 256, 256);
      pg8::EpiKn E{Kn}; pg8::gemm_phase<false, GEMM_ALIGN>(lds, g, S, E, wave_u); }
    { pg8::Gemm g{256, 256, 256}; pg8::Sched S; S.init(4, MR / 256, 1, G, (blockIdx.x + 120) % G, ws + WS_WV, kvn, 0, 0, 1, 256, 256);
      pg8::EpiVt E{Vt}; pg8::gemm_phase<false, GEMM_ALIGN>(lds, g, S, E, wave_u); }
    { pg8::Gemm g{256, 1024, 256}; pg8::Sched S; S.init(MR / 256, 1, 8, G, (blockIdx.x + 112) % G, xc, ws + WS_WMQ, 512, 131072, 4, 1024, 256);
      pg8::EpiBf16 E{mq, 256, (size_t)MR * 256, 1 << 30, 1.f}; pg8::gemm_phase<false, GEMM_ALIGN>(lds, g, S, E, wave_u); }
    { pg8::Gemm g{256, 256, 1024}; pg8::Sched S; S.init(1, MR / 256, 4, G, (blockIdx.x + 104) % G, ws + WS_WMKN, xc, 131072, 512, 4, 256, 1024);
      pg8::EpiBf16 E{mkT, MR, (size_t)256 * MR, 1 << 30, 1.f}; pg8::gemm_phase<false, GEMM_ALIGN>(lds, g, S, E, wave_u); }
    { pg8::Gemm g{256, 256, UW}; pg8::Sched S; S.init(1, MR / 256, 4, G, (blockIdx.x + 96) % G, ws + WS_WMV, ub + O4, 131072, 512, 4, 256, UW);
      pg8::EpiBf16 E{mvT, MR, (size_t)256 * MR, 1 << 30, 1.f}; pg8::gemm_phase<false, GEMM_ALIGN>(lds, g, S, E, wave_u); }
    xcd_barrier(xbar);
    {
        PHASE_VARS
        if (blockIdx.x < 64) { const int uid = blockIdx.x; mlstm_unit(lds, mq, mk, mkT, mvT, gates, ((uid >> 1) & 1) ? hb : hf, (float*)(ws + WS_TAB) + (size_t)(uid >> 1) * 129 * 128, (const void*)(ws + 1024), uid >> 4, (uid >> 2) & 3, (uid >> 1) & 1, uid & 1, wave_u); }
        LAS int* uslot = (LAS int*)(lds + 140000);
        const int tid2 = wave_u * 64 + lane_id_v();
        for (;;) {
            __syncthreads();
            if (tid2 == 0) *uslot = (int)atomicAdd(ctl, 1u);
            __syncthreads();
            const int uid = *uslot;
            if (uid >= 512) break;
            attn_unit(lds, Qb, Kn, Kr, Vt, oatt, uid >> 7, (uid >> 4) & 7, uid & 15, wave_u);
        }
    }
    xcd_barrier(xbar);
    { PHASE_VARS
    for (int row = gw; row < TR; row += NGW) {
        { const bf16_t* op = oatt + (size_t)row * 1024 + 16 * lane; const u32x4 v0 = __builtin_nontemporal_load((const u32x4*)op), v1 = __builtin_nontemporal_load((const u32x4*)(op + 8));
          float f[16] = {bflo(v0.x), bfhi(v0.x), bflo(v0.y), bfhi(v0.y), bflo(v0.z), bfhi(v0.z), bflo(v0.w), bfhi(v0.w), bflo(v1.x), bfhi(v1.x), bflo(v1.y), bfhi(v1.y), bflo(v1.z), bfhi(v1.z), bflo(v1.w), bfhi(v1.w)};
          float ss = 0.f;
#pragma unroll
          for (int i = 0; i < 16; ++i) ss += f[i] * f[i];
          const float rms = 1.f / sqrtf(wave_sum(ss) * (1.f / 1024.f) + 1e-6f); const float* og = args.in[I_AOG] + 16 * lane;
          u32x4 w0, w1;
          w0.x = pk2(f[0] * rms * og[0], f[1] * rms * og[1]); w0.y = pk2(f[2] * rms * og[2], f[3] * rms * og[3]); w0.z = pk2(f[4] * rms * og[4], f[5] * rms * og[5]); w0.w = pk2(f[6] * rms * og[6], f[7] * rms * og[7]);
          w1.x = pk2(f[8] * rms * og[8], f[9] * rms * og[9]); w1.y = pk2(f[10] * rms * og[10], f[11] * rms * og[11]); w1.z = pk2(f[12] * rms * og[12], f[13] * rms * og[13]); w1.w = pk2(f[14] * rms * og[14], f[15] * rms * og[15]);
          *(u32x4*)(ycat + (size_t)row * DM + 16 * lane) = w0; *(u32x4*)(ycat + (size_t)row * DM + 16 * lane + 8) = w1; }
#pragma unroll
        for (int hd = 0; hd < 4; ++hd) { const int c = hd * 256 + 4 * lane;
            const u32x2 a = __builtin_nontemporal_load((const u32x2*)(hf + (size_t)row * 1024 + c)), bq = __builtin_nontemporal_load((const u32x2*)(hb + (size_t)row * 1024 + c)), zz = *(const u32x2*)(ub + (size_t)row * UW + O5 + c), xx = *(const u32x2*)(xc + (size_t)row * 1024 + c);
            float hv[4] = {bflo(a.x) + bflo(bq.x), bfhi(a.x) + bfhi(bq.x), bflo(a.y) + bflo(bq.y), bfhi(a.y) + bfhi(bq.y)};
            const float zf[4] = {bflo(zz.x), bfhi(zz.x), bflo(zz.y), bfhi(zz.y)}, xf[4] = {bflo(xx.x), bfhi(xx.x), bflo(xx.y), bfhi(xx.y)};
#pragma unroll
            for (int i = 0; i < 4; ++i) hv[i] *= sigmf(zf[i]);
            const float mu = wave_sum(hv[0] + hv[1] + hv[2] + hv[3]) * (1.f / 256.f);
            float s2 = 0.f;
#pragma unroll
            for (int i = 0; i < 4; ++i) { hv[i] -= mu; s2 += hv[i] * hv[i]; }
            const float rstd = 1.f / sqrtf(wave_sum(s2) * (1.f / 256.f) + 1e-5f);
            const float* gg = args.in[I_GNG] + c; const float* sk = args.in[I_SKIP] + c;
            u32x2 w; w.x = pk2(hv[0] * rstd * gg[0] + sk[0] * xf[0], hv[1] * rstd * gg[1] + sk[1] * xf[1]); w.y = pk2(hv[2] * rstd * gg[2] + sk[2] * xf[2], hv[3] * rstd * gg[3] + sk[3] * xf[3]);
            *(u32x2*)(ycat + (size_t)row * DM + 1024 + c) = w; }
    } }
    xcd_barrier(xbar);
    { pg8::Gemm g{DM, DM, DM}; pg8::Sched S; S.init(TR / 256, 8, 1, G, blockIdx.x, ycat, ws + WS_WOUT, 0, 0, 1, DM, DM);
      pg8::EpiResid E{h1, (bf16_t*)args.out, 1.0f}; pg8::gemm_phase<GEMM_SP2, GEMM_ALIGN>(lds, g, S, E, wave_u); }
    xcd_barrier(xbar);
    { PHASE_VARS
    for (int row = gw; row < TR; row += NGW) ln_row_b((const bf16_t*)args.out + (size_t)row * DM, args.in[I_LN2G], args.in[I_LN2B], h2 + (size_t)row * DM, nullptr, lane);
    ffn_weights(args.in[I_F2G], args.in[I_F2U], args.in[I_F2D], ws, scr, gw, NGW, lane); }
    xcd_barrier(xbar);
    { pg8::Gemm g{DM, DM, DM}; pg8::Sched S; S.init(TR / 256, 44, 1, G, blockIdx.x, h2, ws + WS_WGU, 0, 0, 1, DM, DM);
      pg8::EpiSwiGLU E{Gb}; pg8::gemm_phase<GEMM_SP2, GEMM_ALIGN>(lds, g, S, E, wave_u); }
    xcd_barrier(xbar);
    { pg8::Gemm g{FF, FF, FF}; pg8::Sched S; S.init(TR / 256, 8, 1, G, blockIdx.x, Gb, ws + WS_WD, 0, 0, 1, FF, FF);
      pg8::EpiResid E{h2, (bf16_t*)(ws + WS_RM), 0.5f}; pg8::gemm_phase<GEMM_SP2, GEMM_ALIGN>(lds, g, S, E, wave_u); }
    xcd_barrier(xbar);
    { PHASE_VARS
    for (int row = gw; row < TR; row += NGW) ln_row_b((const bf16_t*)(ws + WS_RM) + (size_t)row * DM, args.in[I_LN3G], args.in[I_LN3B], nullptr, args.out + (size_t)row * DM, lane); }
}

extern "C" void kernel_launch(void* const* d_in, const int* in_sizes, int n_in, void* d_out, int out_size, void* d_ws, size_t ws_size, hipStream_t stream) {
    static int grid = 0;
    if (grid == 0) {
        if (n_in != 30 || out_size != TR * DM || ws_size < WS_END) { fprintf(stderr, "kernel_launch: unexpected shapes (n_in %d out %d ws %zu need %zu)\n", n_in, out_size, ws_size, (size_t)WS_END); grid = -1; return; }
        int dev = 0, cus = 0, per_cu = 0;
        if (hipGetDevice(&dev) != hipSuccess || hipDeviceGetAttribute(&cus, hipDeviceAttributeMultiprocessorCount, dev) != hipSuccess) { grid = -1; return; }
        if (hipFuncSetAttribute((const void*)fwd_mega, hipFuncAttributeMaxDynamicSharedMemorySize, LDS_BYTES) != hipSuccess) { fprintf(stderr, "hipFuncSetAttribute failed\n"); grid = -1; return; }
        if (hipOccupancyMaxActiveBlocksPerMultiprocessor(&per_cu, (const void*)fwd_mega, NTHR, LDS_BYTES) != hipSuccess || per_cu < 1) fprintf(stderr, "occupancy query: %d\n", per_cu);
        (void)hipGetLastError();
        grid = cus;
        if (grid < 64) { fprintf(stderr, "grid too small\n"); grid = -1; }
    }
    if (grid < 0) return;
    Args a{};
    for (int i = 0; i < 30; ++i) a.in[i] = (const float*)d_in[i];
    a.out = (float*)d_out; a.wsp = (unsigned char*)d_ws;
    (void)hipMemsetAsync(d_ws, 0, 4096 + 16384, stream);
    void* params[] = {&a};
    hipError_t e = hipLaunchCooperativeKernel((const void*)fwd_mega, dim3(grid), dim3(NTHR), params, LDS_BYTES, stream);
    if (e != hipSuccess) fprintf(stderr, "cooperative launch failed: %s (grid %d)\n", hipGetErrorString(e), grid);
}
```

```cpp
#include <hip/hip_runtime.h>
#include <hip/hip_cooperative_groups.h>
#include <cstdio>
#include <cstdint>
namespace cg = cooperative_groups;
#ifndef GEMM_SP2
#define GEMM_SP2 true
#endif
#ifndef GEMM_ALIGN
#define GEMM_ALIGN true
#endif

#define LAS __attribute__((address_space(3)))
typedef unsigned short bf16_t;
typedef short bf16x8 __attribute__((ext_vector_type(8)));
typedef short s16x4 __attribute__((ext_vector_type(4)));
typedef float f32x4 __attribute__((ext_vector_type(4)));
typedef float f32x2 __attribute__((ext_vector_type(2)));
typedef float f32x16 __attribute__((ext_vector_type(16)));
typedef unsigned u32x4 __attribute__((ext_vector_type(4)));
typedef unsigned u32x2 __attribute__((ext_vector_type(2)));

constexpr int DM = 2048, FF = 5632, TR = 16384, MR = 16640, MROWS = 16448, SEQ = 4096, LK = 4160, LTOT = 4112;
constexpr int UW = 3072, O2 = 512, O3 = 768, O4 = 832, O5 = 1856;
constexpr float ALPHA = 1.189207115002721f;
constexpr float QSCALE = 0.07216878364870322f * 1.4426950408889634f;
constexpr int LDS_BYTES = 147456;
constexpr int NTHR = 512;

constexpr size_t WS_CTL = 0;
constexpr size_t WS_BAR = 4096;
constexpr size_t WS_ROPE = 4096 + 16384;
constexpr size_t WS_ZMETA = WS_ROPE + 1052672;
constexpr size_t WS_WIN = WS_ZMETA + 2097152;
constexpr size_t WS_WUQ = WS_WIN + 12582912;
constexpr size_t WS_WK = WS_WUQ + 1572864;
constexpr size_t WS_WV = WS_WK + 524288;
constexpr size_t WS_WMQ = WS_WV + 524288;
constexpr size_t WS_WMK = WS_WMQ + 524288;
constexpr size_t WS_WMV = WS_WMK + 524288;
constexpr size_t WS_WOUT = WS_WMV + 524288;
constexpr size_t WS_KROPE = WS_WOUT + 8388608;
constexpr size_t WS_RW = WS_KROPE + 2129920;
constexpr size_t WS_WGU = WS_RW, WS_WD = WS_RW + 46137344;
constexpr size_t WS_QN = WS_RW, WS_KVN = WS_QN + 17039360, WS_XC = WS_KVN + 8519680, WS_GATES = WS_XC + 34078720;
constexpr size_t WS_RH0 = WS_RW + 69206016;
constexpr size_t WS_H0 = WS_RH0, WS_KN = WS_RH0, WS_VT = WS_RH0 + 34078720, WS_H2 = WS_RH0;
constexpr size_t WS_RG = WS_RH0 + 68157440;
constexpr size_t WS_G = WS_RG, WS_U = WS_RG, WS_OATT = WS_U + 102236160, WS_MKT = WS_OATT + 33554432;
constexpr size_t WS_H1 = WS_RG + 187432960;
constexpr size_t WS_RM = WS_H1 + 68157440;
constexpr size_t WS_MQ = WS_RM, WS_MK = WS_MQ + 34078720, WS_MVT = WS_MK + 34078720, WS_YCAT = WS_RM;
constexpr size_t WS_WGT = WS_RM + 102236160;
constexpr size_t WS_TAB = WS_WGT + 65536;
constexpr size_t WS_WMKN = WS_TAB + 64 * 129 * 512;
constexpr size_t WS_END = WS_WMKN + 524288;
static_assert(WS_MKT + 34078720 <= WS_H1, "RG overlay");
static_assert(WS_GATES + 1064960 <= WS_RH0, "RW overlay");
static_assert(WS_END <= 536870912ull, "workspace");
constexpr size_t DO_Q = 0, DO_HF = 50331648, DO_HB = DO_HF + 33554432;

__device__ __forceinline__ unsigned f2bf(float f) { unsigned u = __builtin_bit_cast(unsigned, f); return (u + 0x7fffu + ((u >> 16) & 1u)) >> 16; }
typedef __bf16 bf16x2_t __attribute__((ext_vector_type(2)));
__device__ __forceinline__ unsigned cvtpk(float lo, float hi) { const f32x2 v = {lo, hi}; const bf16x2_t b = __builtin_convertvector(v, bf16x2_t); return __builtin_bit_cast(unsigned, b); }
__device__ __forceinline__ unsigned pk2(float lo, float hi) { return cvtpk(lo, hi); }
__device__ __forceinline__ float bflo(unsigned u) { return __builtin_bit_cast(float, u << 16); }
__device__ __forceinline__ float bfhi(unsigned u) { return __builtin_bit_cast(float, u & 0xffff0000u); }
__device__ __forceinline__ float bf1(bf16_t h) { return __builtin_bit_cast(float, (unsigned)h << 16); }
__device__ __forceinline__ float wave_sum(float v) {
#pragma unroll
    for (int o = 1; o < 64; o <<= 1) v += __shfl_xor(v, o);
    return v;
}
__device__ __forceinline__ float siluf(float x) { return x * __builtin_amdgcn_rcpf(1.f + __builtin_amdgcn_exp2f(-1.4426950408889634f * x)); }
__device__ __forceinline__ float sigmf(float x) { return __builtin_amdgcn_rcpf(1.f + __builtin_amdgcn_exp2f(-1.4426950408889634f * x)); }
__device__ __forceinline__ int lane_id_v() { int l; asm volatile("v_mbcnt_lo_u32_b32 %0, -1, 0\n\tv_mbcnt_hi_u32_b32 %0, -1, %0" : "=v"(l)); return l; }
__device__ __forceinline__ float shx(float v, int lane, int m) { return __builtin_bit_cast(float, __builtin_amdgcn_ds_bpermute((lane ^ m) << 2, __builtin_bit_cast(int, v))); }
__device__ __forceinline__ float shl(float v, int src) { return __builtin_bit_cast(float, __builtin_amdgcn_ds_bpermute(src << 2, __builtin_bit_cast(int, v))); }
#define LDS_WAIT() asm volatile("s_waitcnt lgkmcnt(0)" ::: "memory")

namespace pg8 {
constexpr int BM = 256, BK = 64, HALF = 128, HTB = HALF * BK * 2, STAGE_BYTES = 8 * HTB, NXCD = 8, WGM = 8;
__host__ __device__ __forceinline__ int lds_byte(int r, int c) { const int st = (r >> 4) * 2 + (c >> 5), rr = r & 15, cc = c & 31, ob = rr * 64 + cc * 2; return st * 1024 + (ob ^ (((ob >> 9) & 1) << 5)); }
__host__ __device__ __forceinline__ void stage_rc(int b, int& R, int& C) { const int st = b / 1024, sb = b % 1024, swz = sb ^ (((sb >> 9) & 1) << 5); R = (st >> 1) * 16 + swz / 64; C = (st & 1) * 32 + (swz % 64) / 2; }
__host__ __device__ __forceinline__ int perm32(int rho) { const int n = rho >> 4, i = rho & 15; return 8 * (i >> 2) + 4 * n + (i & 3); }

struct Unit { int pm, pn, g; const char* a; const char* b; };
__device__ __forceinline__ const char* uptr(const char* p) { const unsigned long long v = (unsigned long long)p; const unsigned lo = __builtin_amdgcn_readfirstlane((unsigned)v), hi = __builtin_amdgcn_readfirstlane((unsigned)(v >> 32)); return (const char*)(((unsigned long long)hi << 32) | lo); }
struct Gemm { int K, lda, ldb; };

struct Sched {
    int nM, nN, nwg, total, G, c; const char* A0; const char* B0; size_t aG, bG, tA, tB; int gmodA;
    __device__ void init(int nM_, int nN_, int ngrp, int G_, int c_, const void* A0_, const void* B0_, size_t aG_, size_t bG_, int gmodA_, int lda, int ldb) {
        nM = nM_; nN = nN_; nwg = nM * nN; total = nwg * ngrp; G = G_; c = c_; A0 = (const char*)A0_; B0 = (const char*)B0_; aG = aG_; bG = bG_; gmodA = gmodA_;
        tA = (size_t)256 * lda * 2; tB = (size_t)256 * ldb * 2;
    }
    __device__ bool next(int i, Unit& u) const {
        const int L = i * G + c; if (L >= total) return false;
        const int g = L / nwg; int wgid = L - g * nwg;
        { const int q = nwg / NXCD, r = nwg % NXCD, xcd = wgid % NXCD, off = wgid / NXCD; wgid = (xcd < r ? xcd * (q + 1) : r * (q + 1) + (xcd - r) * q) + off; }
        const int nig = WGM * nN, gid = wgid / nig, fm = gid * WGM, gsz = (nM - fm) < WGM ? (nM - fm) : WGM;
        u.pm = __builtin_amdgcn_readfirstlane(fm + ((wgid % nig) % gsz)); u.pn = __builtin_amdgcn_readfirstlane((wgid % nig) / gsz); u.g = __builtin_amdgcn_readfirstlane(g);
        u.a = uptr(A0 + (size_t)(u.g % gmodA) * aG + (size_t)u.pm * tA); u.b = uptr(B0 + (size_t)u.g * bG + (size_t)u.pn * tB);
        return true;
    }
};

__device__ __forceinline__ unsigned cvt_pk_bf16(float lo, float hi) { unsigned r; asm volatile("v_cvt_pk_bf16_f32 %0, %1, %2" : "=v"(r) : "v"(lo), "v"(hi)); return r; }

template <bool SP2, bool ALIGN_EPI, class Epi>
__device__ __forceinline__ void gemm_phase(LAS unsigned char* lds, const Gemm g, const Sched& S, const Epi& E, int wave_u) {
    int tid = wave_u * 64 + lane_id_v();
    const int wid = __builtin_amdgcn_readfirstlane(tid >> 6), lane = tid & 63, wr = wid >> 2, wc = wid & 3, fr = lane & 15, fq = lane >> 4;
    const int K = g.K, nt = K / BK;
    unsigned voffA[2], voffB[2];
#pragma unroll
    for (int i = 0; i < 2; ++i) { int R, C; stage_rc(tid * 16 + i * 8192, R, C); const int Rb = (R & ~31) + perm32(R & 31);
        voffA[i] = (unsigned)(R * g.lda + C) * 2u; voffB[i] = (unsigned)(Rb * g.ldb + C) * 2u; }
    const size_t kstep = (size_t)(BK * 2);
    const size_t hstepA = (size_t)HALF * g.lda * 2, hstepB = (size_t)HALF * g.ldb * 2;
    const unsigned ldsw = (unsigned)wid * 1024u;
    const int aoff = lds_byte(wr * 64 + fr, fq * 8), boff = lds_byte(wc * 32 + fr, fq * 8);
#define PG8_SA(b, h) (((b) * 2 + (h)) * HTB)
#define PG8_SB(b, h) ((4 + (b) * 2 + (h)) * HTB)
#define PG8_STAGE(bufoff, gbase, voff) do { _Pragma("unroll") for (int _i = 0; _i < 2; ++_i) \
        __builtin_amdgcn_global_load_lds((const unsigned*)((const char*)(gbase) + (voff)[_i]), (LAS unsigned*)(lds + (bufoff) + ldsw + _i * 8192), 16, 0, 0); } while (0)
#define PG8_LDA(dst, b, h) do { _Pragma("unroll") for (int m = 0; m < 4; ++m) _Pragma("unroll") for (int k = 0; k < 2; ++k) dst[m][k] = *(const LAS bf16x8*)(lds + PG8_SA(b, h) + aoff + m * 2048 + k * 1024); } while (0)
#define PG8_LDB(dst, b, h) do { _Pragma("unroll") for (int n = 0; n < 2; ++n) _Pragma("unroll") for (int k = 0; k < 2; ++k) dst[n][k] = *(const LAS bf16x8*)(lds + PG8_SB(b, h) + boff + n * 2048 + k * 1024); } while (0)
#define PG8_MMA(ai, bj, At, Bt) do { __builtin_amdgcn_s_setprio(1); _Pragma("unroll") for (int m = 0; m < 4; ++m) _Pragma("unroll") for (int n = 0; n < 2; ++n) _Pragma("unroll") for (int k = 0; k < 2; ++k) \
        acc[ai][bj][m][n] = __builtin_amdgcn_mfma_f32_16x16x32_bf16(Bt[n][k], At[m][k], acc[ai][bj][m][n], 0, 0, 0); __builtin_amdgcn_s_setprio(0); } while (0)
#define PG8_WAIT_V(n) asm volatile("s_waitcnt vmcnt(" #n ")" ::: "memory")
#define PG8_WAIT_L(n) asm volatile("s_waitcnt lgkmcnt(" #n ")" ::: "memory")
#define PG8_BAR __builtin_amdgcn_s_barrier()
#define PG8_SCHED __builtin_amdgcn_sched_barrier(0)
    Unit cur, nxt; int ui = 0;
    if (!S.next(0, cur)) return;
    f32x4 acc[2][2][4][2];
#pragma unroll
    for (int a = 0; a < 2; ++a)
#pragma unroll
        for (int b = 0; b < 2; ++b)
#pragma unroll
            for (int m = 0; m < 4; ++m)
#pragma unroll
                for (int n = 0; n < 2; ++n) acc[a][b][m][n] = (f32x4){0.f, 0.f, 0.f, 0.f};
    bf16x8 At[4][2], B0[2][2], B1[2][2];
    const char* cA = cur.a; const char* cB = cur.b;
    if constexpr (SP2) {
        PG8_STAGE(PG8_SB(0, 0), cB, voffB); PG8_STAGE(PG8_SB(0, 1), cB + hstepB, voffB); PG8_STAGE(PG8_SA(0, 0), cA, voffA); PG8_STAGE(PG8_SA(0, 1), cA + hstepA, voffA);
        if (wr == 1) PG8_BAR;
        PG8_WAIT_V(2); PG8_BAR;
        PG8_STAGE(PG8_SB(1, 0), cB + kstep, voffB); PG8_STAGE(PG8_SA(1, 0), cA + kstep, voffA); PG8_STAGE(PG8_SB(1, 1), cB + hstepB + kstep, voffB);
        PG8_WAIT_V(6); PG8_BAR;
    } else {
        PG8_STAGE(PG8_SB(0, 0), cB, voffB); PG8_STAGE(PG8_SA(0, 0), cA, voffA); PG8_STAGE(PG8_SB(0, 1), cB + hstepB, voffB); PG8_STAGE(PG8_SA(0, 1), cA + hstepA, voffA);
        if (wr == 1) PG8_BAR;
        PG8_WAIT_V(4); PG8_BAR;
        PG8_STAGE(PG8_SB(1, 0), cB + kstep, voffB); PG8_STAGE(PG8_SA(1, 0), cA + kstep, voffA); PG8_STAGE(PG8_SB(1, 1), cB + hstepB + kstep, voffB);
        PG8_WAIT_V(6); PG8_BAR;
    }
    for (;;) {
        const bool has_next = S.next(ui + 1, nxt);
        const char* nA = has_next ? nxt.a : cA; const char* nB = has_next ? nxt.b : cB;
#pragma unroll 1
        for (int t = 0; t < nt; t += 2) {
            const bool last = (t == nt - 2);
            const char* a1 = cA + (size_t)(t + 1) * kstep;
            const char* a2 = last ? nA : cA + (size_t)(t + 2) * kstep; const char* b2 = last ? nB : cB + (size_t)(t + 2) * kstep;
            const char* a3 = a2 + kstep; const char* b3 = b2 + kstep;
            if constexpr (SP2) {
            PG8_LDB(B0, 0, 0); PG8_LDB(B1, 0, 1); PG8_SCHED; PG8_LDA(At, 0, 0); PG8_STAGE(PG8_SA(1, 1), a1 + hstepA, voffA);
            PG8_WAIT_V(8); PG8_WAIT_L(0); PG8_BAR; PG8_MMA(0, 0, At, B0); PG8_MMA(0, 1, At, B1); PG8_BAR; PG8_SCHED;
            PG8_LDA(At, 0, 1); PG8_STAGE(PG8_SB(0, 0), b2, voffB); PG8_STAGE(PG8_SB(0, 1), b2 + hstepB, voffB); PG8_STAGE(PG8_SA(0, 0), a2, voffA);
            PG8_WAIT_V(8); PG8_WAIT_L(0); PG8_BAR; PG8_MMA(1, 0, At, B0); PG8_MMA(1, 1, At, B1); PG8_BAR; PG8_SCHED;
            PG8_LDB(B0, 1, 0); PG8_LDB(B1, 1, 1); PG8_SCHED; PG8_LDA(At, 1, 0); PG8_STAGE(PG8_SA(0, 1), a2 + hstepA, voffA);
            PG8_WAIT_V(8); PG8_WAIT_L(0); PG8_BAR; PG8_MMA(0, 0, At, B0); PG8_MMA(0, 1, At, B1); PG8_BAR; PG8_SCHED;
            PG8_LDA(At, 1, 1); PG8_STAGE(PG8_SB(1, 0), b3, voffB); PG8_STAGE(PG8_SB(1, 1), b3 + hstepB, voffB); PG8_STAGE(PG8_SA(1, 0), a3, voffA);
            PG8_WAIT_V(8); PG8_WAIT_L(0); PG8_BAR; PG8_MMA(1, 0, At, B0); PG8_MMA(1, 1, At, B1); PG8_BAR; PG8_SCHED;
            } else {
            PG8_LDB(B0, 0, 0); PG8_SCHED; PG8_LDA(At, 0, 0); PG8_STAGE(PG8_SA(1, 1), a1 + hstepA, voffA);
            PG8_WAIT_L(8); PG8_BAR; PG8_WAIT_L(0); PG8_MMA(0, 0, At, B0); PG8_BAR; PG8_SCHED;
            PG8_LDB(B1, 0, 1); PG8_STAGE(PG8_SB(0, 0), b2, voffB);
            PG8_BAR; PG8_WAIT_L(0); PG8_MMA(0, 1, At, B1); PG8_BAR;
            PG8_LDA(At, 0, 1); PG8_STAGE(PG8_SA(0, 0), a2, voffA);
            PG8_BAR; PG8_WAIT_L(0); PG8_MMA(1, 0, At, B0); PG8_BAR; PG8_SCHED;
            PG8_STAGE(PG8_SB(0, 1), b2 + hstepB, voffB);
            PG8_WAIT_V(6); PG8_BAR; PG8_MMA(1, 1, At, B1); PG8_BAR;
            PG8_LDB(B0, 1, 0); PG8_SCHED; PG8_LDA(At, 1, 0); PG8_STAGE(PG8_SA(0, 1), a2 + hstepA, voffA);
            PG8_WAIT_L(8); PG8_BAR; PG8_WAIT_L(0); PG8_MMA(0, 0, At, B0); PG8_BAR; PG8_SCHED;
            PG8_LDB(B1, 1, 1); PG8_STAGE(PG8_SB(1, 0), b3, voffB);
            PG8_BAR; PG8_WAIT_L(0); PG8_MMA(0, 1, At, B1); PG8_BAR;
            PG8_LDA(At, 1, 1); PG8_STAGE(PG8_SA(1, 0), a3, voffA);
            PG8_BAR; PG8_WAIT_L(0); PG8_MMA(1, 0, At, B0); PG8_BAR; PG8_SCHED;
            PG8_STAGE(PG8_SB(1, 1), b3 + hstepB, voffB);
            PG8_WAIT_V(6); PG8_BAR; PG8_MMA(1, 1, At, B1); PG8_BAR;
            }
        }
        if constexpr (ALIGN_EPI) { if (wr == 0) PG8_BAR; }
        E(acc, cur, wr, wc, fr, fq);
        if (!has_next) break;
#pragma unroll
        for (int a = 0; a < 2; ++a)
#pragma unroll
            for (int b = 0; b < 2; ++b)
#pragma unroll
                for (int m = 0; m < 4; ++m)
#pragma unroll
                    for (int n = 0; n < 2; ++n) acc[a][b][m][n] = (f32x4){0.f, 0.f, 0.f, 0.f};
        cur = nxt; cA = nA; cB = nB; ++ui;
        if constexpr (ALIGN_EPI) { if (wr == 1) PG8_BAR; }
    }
    PG8_WAIT_V(0);
    if constexpr (!ALIGN_EPI) { if (wr == 0) PG8_BAR; }
    PG8_BAR;
#undef PG8_SA
#undef PG8_SB
#undef PG8_STAGE
#undef PG8_LDA
#undef PG8_LDB
#undef PG8_MMA
#undef PG8_WAIT_V
#undef PG8_WAIT_L
#undef PG8_BAR
#undef PG8_SCHED
}

#define EPI_LOOP_ROWS for (int ai = 0; ai < 2; ++ai) for (int m = 0; m < 4; ++m, __builtin_amdgcn_sched_barrier(0))
struct EpiSwiGLU {
    bf16_t* G;
    __device__ __forceinline__ void operator()(const f32x4 (&acc)[2][2][4][2], const Unit& u, int wr, int wc, int fr, int fq) const {
        const int col = u.pn * 128 + wc * 32 + fq * 8;
#pragma unroll
        EPI_LOOP_ROWS { const int row = u.pm * 256 + ai * 128 + wr * 64 + m * 16 + fr;
            float o[8];
#pragma unroll
            for (int n = 0; n < 2; ++n)
#pragma unroll
                for (int j = 0; j < 4; ++j) o[n * 4 + j] = siluf(acc[ai][0][m][n][j]) * acc[ai][1][m][n][j];
            u32x4 w; w.x = pk2(o[0], o[1]); w.y = pk2(o[2], o[3]); w.z = pk2(o[4], o[5]); w.w = pk2(o[6], o[7]);
            *(u32x4*)(G + (size_t)row * FF + col) = w; }
    }
};
struct EpiResid {
    const bf16_t* res; bf16_t* zb; float sc;
    __device__ __forceinline__ void operator()(const f32x4 (&acc)[2][2][4][2], const Unit& u, int wr, int wc, int fr, int fq) const {
#pragma unroll
        EPI_LOOP_ROWS { const int row = u.pm * 256 + ai * 128 + wr * 64 + m * 16 + fr;
#pragma unroll
            for (int bj = 0; bj < 2; ++bj) { const int col = u.pn * 256 + bj * 128 + wc * 32 + fq * 8;
                const u32x4 rv = *(const u32x4*)(res + (size_t)row * DM + col);
                u32x4 w;
                w.x = pk2(ALPHA * bflo(rv.x) + sc * acc[ai][bj][m][0][0], ALPHA * bfhi(rv.x) + sc * acc[ai][bj][m][0][1]);
                w.y = pk2(ALPHA * bflo(rv.y) + sc * acc[ai][bj][m][0][2], ALPHA * bfhi(rv.y) + sc * acc[ai][bj][m][0][3]);
                w.z = pk2(ALPHA * bflo(rv.z) + sc * acc[ai][bj][m][1][0], ALPHA * bfhi(rv.z) + sc * acc[ai][bj][m][1][1]);
                w.w = pk2(ALPHA * bflo(rv.w) + sc * acc[ai][bj][m][1][2], ALPHA * bfhi(rv.w) + sc * acc[ai][bj][m][1][3]);
                *(u32x4*)(zb + (size_t)row * DM + col) = w; }
        }
    }
};
struct EpiBf16 {
    bf16_t* O; int ldc; size_t gstride; int gscale_from; float sc;
    __device__ __forceinline__ void operator()(const f32x4 (&acc)[2][2][4][2], const Unit& u, int wr, int wc, int fr, int fq) const {
        const float s = (u.g >= gscale_from) ? sc : 1.f;
        bf16_t* base = O + (size_t)u.g * gstride;
#pragma unroll
        EPI_LOOP_ROWS { const int row = u.pm * 256 + ai * 128 + wr * 64 + m * 16 + fr;
#pragma unroll
            for (int bj = 0; bj < 2; ++bj) { const int col = u.pn * 256 + bj * 128 + wc * 32 + fq * 8;
                const f32x4 v0 = acc[ai][bj][m][0] * s, v1 = acc[ai][bj][m][1] * s;
                u32x4 w; w.x = pk2(v0[0], v0[1]); w.y = pk2(v0[2], v0[3]); w.z = pk2(v1[0], v1[1]); w.w = pk2(v1[2], v1[3]);
                *(u32x4*)(base + (size_t)row * ldc + col) = w; }
        }
    }
};
struct EpiQ {
    bf16_t* Q; const f32x2* rope;
    __device__ __forceinline__ void operator()(const f32x4 (&acc)[2][2][4][2], const Unit& u, int wr, int wc, int fr, int fq) const {
#pragma unroll
        EPI_LOOP_ROWS { const int row = u.pm * 256 + ai * 128 + wr * 64 + m * 16 + fr;
            const int b = row >> 12, s = row & 4095;
            if (u.pn < 4) {
#pragma unroll
                for (int bj = 0; bj < 2; ++bj) { const int h = u.pn * 2 + bj, d = wc * 32 + fq * 8;
                    const f32x4 v0 = acc[ai][bj][m][0] * QSCALE, v1 = acc[ai][bj][m][1] * QSCALE;
                    u32x4 w; w.x = pk2(v0[0], v0[1]); w.y = pk2(v0[2], v0[3]); w.z = pk2(v1[0], v1[1]); w.w = pk2(v1[2], v1[3]);
                    *(u32x4*)(Q + ((size_t)(b * 8 + h) * SEQ + s) * 192 + d) = w; }
            } else {
                const int p0 = (u.pn - 4) * 128 + wc * 32 + fq * 8, h = p0 >> 5, i0 = p0 & 31;
                const f32x2* rp = rope + (size_t)(16 + s) * 32 + i0;
                float o1[8], o2[8];
#pragma unroll
                for (int n = 0; n < 2; ++n)
#pragma unroll
                    for (int j = 0; j < 4; ++j) { const f32x2 cs = rp[n * 4 + j]; const float x1 = acc[ai][0][m][n][j], x2 = acc[ai][1][m][n][j];
                        o1[n * 4 + j] = (x1 * cs.x - x2 * cs.y) * QSCALE; o2[n * 4 + j] = (x2 * cs.x + x1 * cs.y) * QSCALE; }
                bf16_t* qp = Q + ((size_t)(b * 8 + h) * SEQ + s) * 192 + 128 + i0;
                u32x4 w; w.x = pk2(o1[0], o1[1]); w.y = pk2(o1[2], o1[3]); w.z = pk2(o1[4], o1[5]); w.w = pk2(o1[6], o1[7]);
                *(u32x4*)qp = w;
                w.x = pk2(o2[0], o2[1]); w.y = pk2(o2[2], o2[3]); w.z = pk2(o2[4], o2[5]); w.w = pk2(o2[6], o2[7]);
                *(u32x4*)(qp + 32) = w;
            }
        }
    }
};
struct EpiKn {
    bf16_t* Kn;
    __device__ __forceinline__ void operator()(const f32x4 (&acc)[2][2][4][2], const Unit& u, int wr, int wc, int fr, int fq) const {
#pragma unroll
        EPI_LOOP_ROWS { const int row = u.pm * 256 + ai * 128 + wr * 64 + m * 16 + fr;
            if (row < MROWS) {
                int b, key; if (row < TR) { b = row >> 12; key = row & 4095; } else { b = (row - TR) >> 4; key = SEQ + ((row - TR) & 15); }
#pragma unroll
                for (int bj = 0; bj < 2; ++bj) { const int h = u.pn * 2 + bj, d = wc * 32 + fq * 8;
                    const f32x4 v0 = acc[ai][bj][m][0], v1 = acc[ai][bj][m][1];
                    u32x4 w; w.x = pk2(v0[0], v0[1]); w.y = pk2(v0[2], v0[3]); w.z = pk2(v1[0], v1[1]); w.w = pk2(v1[2], v1[3]);
                    *(u32x4*)(Kn + ((size_t)(b * 8 + h) * LK + key) * 128 + d) = w; }
            }
        }
    }
};
struct EpiVt {
    bf16_t* Vt;
    __device__ __forceinline__ void operator()(const f32x4 (&acc)[2][2][4][2], const Unit& u, int wr, int wc, int fr, int fq) const {
#pragma unroll
        EPI_LOOP_ROWS { const int f = u.pm * 256 + ai * 128 + wr * 64 + m * 16 + fr, h = f >> 7, d = f & 127;
#pragma unroll
            for (int bj = 0; bj < 2; ++bj) { const int row = u.pn * 256 + bj * 128 + wc * 32 + fq * 8;
                if (row < MROWS) {
                    int b, key; if (row < TR) { b = row >> 12; key = row & 4095; } else { b = (row - TR) >> 4; key = SEQ + ((row - TR) & 15); }
                    const f32x4 v0 = acc[ai][bj][m][0], v1 = acc[ai][bj][m][1];
                    u32x4 w; w.x = pk2(v0[0], v0[1]); w.y = pk2(v0[2], v0[3]); w.z = pk2(v1[0], v1[1]); w.w = pk2(v1[2], v1[3]);
                    bf16_t* vp = Vt + ((size_t)(b * 8 + h) * 128 + d) * LK + (key & ~15);
                    const int hi8 = (key >> 3) & 1;
                    *(u32x2*)(vp + (hi8 ? 4 : 0)) = (u32x2){w.x, w.y}; *(u32x2*)(vp + (hi8 ? 12 : 8)) = (u32x2){w.z, w.w}; }
            }
        }
    }
};
}

struct Args { const float* in[30]; float* out; unsigned char* wsp; };
enum { I_X = 0, I_META, I_F1G, I_F1U, I_F1D, I_LN1G, I_LN1B, I_WIN, I_QNG, I_WUQ, I_KVNG, I_WUKV, I_AOG, I_CW, I_CB, I_MWQ, I_MWK, I_MWV, I_WG, I_BG, I_GNG, I_SKIP,
       I_WOUT, I_LN2G, I_LN2B, I_F2G, I_F2U, I_F2D, I_LN3G, I_LN3B };

__device__ __forceinline__ int perm_qk(int n) { return n < 16 ? 8 * (n >> 2) + (n & 3) : 8 * ((n - 16) >> 2) + 4 + (n & 3); }
__device__ __forceinline__ void tr_item(const float* W, int N, bf16_t* WT, int ldt, int dst_row, int k0, int n0, LAS float* scr, int lane, float scale, bool perm = false) {
#pragma unroll 8
    for (int i = 0; i < 32; ++i) { const int kk = 2 * i + (lane >> 5); scr[kk * 33 + (lane & 31)] = __builtin_nontemporal_load(&W[(size_t)(k0 + kk) * N + n0 + (lane & 31)]); }
    LDS_WAIT(); asm volatile("" ::: "memory");
    const int c = lane & 7;
#pragma unroll
    for (int j = 0; j < 4; ++j) { const int n = (lane >> 3) + 8 * j; const LAS float* s = scr + (8 * c) * 33 + n;
        u32x4 o; o.x = pk2(s[0 * 33] * scale, s[1 * 33] * scale); o.y = pk2(s[2 * 33] * scale, s[3 * 33] * scale); o.z = pk2(s[4 * 33] * scale, s[5 * 33] * scale); o.w = pk2(s[6 * 33] * scale, s[7 * 33] * scale);
        *(u32x4*)(WT + (size_t)(dst_row + (perm ? perm_qk(n) : n)) * ldt + k0 + 8 * c) = o; }
    LDS_WAIT(); asm volatile("" ::: "memory");
}
__device__ __forceinline__ void ffn_weights(const float* Wg, const float* Wu, const float* Wd, unsigned char* ws, LAS float* scr, int gw, int NGW, int lane) {
    bf16_t* Wgu = (bf16_t*)(ws + WS_WGU); bf16_t* Wdt = (bf16_t*)(ws + WS_WD);
    for (int it = gw; it < 3 * 5632; it += NGW) {
        const int mat = it / 5632, r = it % 5632;
        if (mat < 2) { const int kb = r / 176, nb = r % 176, n0 = nb * 32; tr_item(mat ? Wu : Wg, FF, Wgu, DM, (n0 >> 7) * 256 + mat * 128 + (n0 & 127), kb * 64, n0, scr, lane, 1.f); }
        else { const int kb = r / 64, nb = r % 64; tr_item(Wd, DM, Wdt, FF, nb * 32, kb * 64, nb * 32, scr, lane, 1.f); }
    }
}
__device__ __forceinline__ void ln_row_b(const bf16_t* zr, const float* g, const float* bb, bf16_t* ob, float* of, int lane) {
    f32x4 v[8]; float s = 0.f;
#pragma unroll
    for (int j = 0; j < 4; ++j) { const u32x4 r = __builtin_nontemporal_load((const u32x4*)(zr + 8 * (lane + 64 * j)));
        v[2 * j] = (f32x4){bflo(r.x), bfhi(r.x), bflo(r.y), bfhi(r.y)}; v[2 * j + 1] = (f32x4){bflo(r.z), bfhi(r.z), bflo(r.w), bfhi(r.w)};
        s += (v[2 * j][0] + v[2 * j][1]) + (v[2 * j][2] + v[2 * j][3]) + (v[2 * j + 1][0] + v[2 * j + 1][1]) + (v[2 * j + 1][2] + v[2 * j + 1][3]); }
    const float mean = wave_sum(s) * (1.f / DM); float s2 = 0.f;
#pragma unroll
    for (int j = 0; j < 8; ++j) { v[j] = v[j] - mean; s2 += (v[j][0] * v[j][0] + v[j][1] * v[j][1]) + (v[j][2] * v[j][2] + v[j][3] * v[j][3]); }
    const float rstd = 1.f / sqrtf(wave_sum(s2) * (1.f / DM) + 1e-5f);
#pragma unroll
    for (int j = 0; j < 4; ++j) { const int c = 8 * (lane + 64 * j);
        const f32x4 o0 = v[2 * j] * rstd * *(const f32x4*)(g + c) + *(const f32x4*)(bb + c), o1 = v[2 * j + 1] * rstd * *(const f32x4*)(g + c + 4) + *(const f32x4*)(bb + c + 4);
        if (ob) { u32x4 w; w.x = pk2(o0[0], o0[1]); w.y = pk2(o0[2], o0[3]); w.z = pk2(o1[0], o1[1]); w.w = pk2(o1[2], o1[3]); *(u32x4*)(ob + c) = w; }
        else { __builtin_nontemporal_store(o0, (f32x4*)(of + c)); __builtin_nontemporal_store(o1, (f32x4*)(of + c + 4)); } }
}
__device__ __forceinline__ void ln_row(const float* zr, const float* g, const float* bb, bf16_t* ob, float* of, int lane) {
    f32x4 v[8]; float s = 0.f;
#pragma unroll
    for (int j = 0; j < 8; ++j) { v[j] = *(const f32x4*)(zr + 4 * (lane + 64 * j)); s += (v[j][0] + v[j][1]) + (v[j][2] + v[j][3]); }
    const float mean = wave_sum(s) * (1.f / DM); float s2 = 0.f;
#pragma unroll
    for (int j = 0; j < 8; ++j) { v[j] = v[j] - mean; s2 += (v[j][0] * v[j][0] + v[j][1] * v[j][1]) + (v[j][2] * v[j][2] + v[j][3] * v[j][3]); }
    const float rstd = 1.f / sqrtf(wave_sum(s2) * (1.f / DM) + 1e-5f);
#pragma unroll
    for (int j = 0; j < 8; ++j) { const int c = 4 * (lane + 64 * j); const f32x4 gg = *(const f32x4*)(g + c), b4 = *(const f32x4*)(bb + c);
        const f32x4 o = v[j] * rstd * gg + b4;
        if (ob) { u32x2 w; w.x = pk2(o[0], o[1]); w.y = pk2(o[2], o[3]); *(u32x2*)(ob + c) = w; } else *(f32x4*)(of + c) = o; }
}

__device__ __forceinline__ void attn_unit(LAS unsigned char* lds, const bf16_t* Q, const bf16_t* Kn, const bf16_t* Kr, const bf16_t* Vt, bf16_t* O, int b, int h, int qb, int wave_u) {
    int tid = wave_u * 64 + lane_id_v();
    const int wave = tid >> 6, lane = tid & 63, r = lane & 31, hh = lane >> 5;
    constexpr int ABUF = 44032;
    const bf16_t* qrow = Q + ((size_t)(b * 8 + h) * SEQ + qb * 256 + wave * 32 + r) * 192;
    bf16x8 qf[12];
#pragma unroll
    for (int ks = 0; ks < 12; ++ks) qf[ks] = *(const bf16x8*)(qrow + 16 * ks + 8 * hh);
    f32x16 oacc[4];
#pragma unroll
    for (int i = 0; i < 4; ++i)
#pragma unroll
        for (int j = 0; j < 16; ++j) oacc[i][j] = 0.f;
    float mrun = 0.f, lrun = 0.f;
    const bf16_t* Knb = Kn + (size_t)(b * 8 + h) * LK * 128; const bf16_t* Krb = Kr + (size_t)b * LK * 64; const bf16_t* Vtb = Vt + (size_t)(b * 8 + h) * 128 * LK;
    u32x4 pk[2], pr, pv[2];
    const int kc0 = tid, kc1 = tid + 512;
#define ATT_LOAD(kt) do { \
        pk[0] = *(const u32x4*)(Knb + (size_t)((kt) * 64 + (kc0 >> 4)) * 128 + (kc0 & 15) * 8); \
        pk[1] = *(const u32x4*)(Knb + (size_t)((kt) * 64 + (kc1 >> 4)) * 128 + (kc1 & 15) * 8); \
        pr = *(const u32x4*)(Krb + (size_t)((kt) * 64 + (tid >> 3)) * 64 + (tid & 7) * 8); \
        pv[0] = *(const u32x4*)(Vtb + (size_t)(kc0 >> 3) * LK + (kt) * 64 + (kc0 & 7) * 8); \
        pv[1] = *(const u32x4*)(Vtb + (size_t)(kc1 >> 3) * LK + (kt) * 64 + (kc1 & 7) * 8); } while (0)
#define ATT_STORE() do { \
        *(LAS u32x4*)(Ks + (kc0 >> 4) * 400 + (kc0 & 15) * 16) = pk[0]; \
        *(LAS u32x4*)(Ks + (kc1 >> 4) * 400 + (kc1 & 15) * 16) = pk[1]; \
        *(LAS u32x4*)(Ks + (tid >> 3) * 400 + 256 + (tid & 7) * 16) = pr; \
        *(LAS u32x4*)(Vs + (kc0 >> 3) * 144 + (kc0 & 7) * 16) = pv[0]; \
        *(LAS u32x4*)(Vs + (kc1 >> 3) * 144 + (kc1 & 7) * 16) = pv[1]; } while (0)
    ATT_LOAD(0);
    { LAS unsigned char* Ks = lds; LAS unsigned char* Vs = lds + 25600;
      ATT_STORE();
      ATT_LOAD(1); }
    for (int kt = 0; kt < 65; ++kt) {
        __syncthreads();
        LAS unsigned char* Ks = lds + (kt & 1) * ABUF; LAS unsigned char* Vs = Ks + 25600;
        f32x16 s0, s1;
        { const float negm = -mrun;
#pragma unroll
          for (int j = 0; j < 16; ++j) { s0[j] = negm; s1[j] = negm; } }
        {
            bf16x8 fa[3][4];
            const LAS unsigned char* k0p = Ks + r * 400 + hh * 16; const LAS unsigned char* k1p = k0p + 32 * 400;
#define ATT_RK(g, bf) do { fa[bf][0] = *(const LAS bf16x8*)(k0p + (2 * (g)) * 32); fa[bf][1] = *(const LAS bf16x8*)(k1p + (2 * (g)) * 32); \
                           fa[bf][2] = *(const LAS bf16x8*)(k0p + (2 * (g) + 1) * 32); fa[bf][3] = *(const LAS bf16x8*)(k1p + (2 * (g) + 1) * 32); } while (0)
            ATT_RK(0, 0); ATT_RK(1, 1);
            __builtin_amdgcn_sched_barrier(0);
            if (kt + 1 < 65) { LAS unsigned char* Ks = lds + ((kt + 1) & 1) * ABUF; LAS unsigned char* Vs = Ks + 25600; ATT_STORE(); }
            if (kt + 2 < 65) ATT_LOAD(kt + 2);
#pragma unroll
            for (int g = 0; g < 6; ++g) {
                if (g + 2 < 6) ATT_RK(g + 2, (g + 2) % 3);
                __builtin_amdgcn_sched_barrier(0);
                s0 = __builtin_amdgcn_mfma_f32_32x32x16_bf16(fa[g % 3][0], qf[2 * g], s0, 0, 0, 0);
                s1 = __builtin_amdgcn_mfma_f32_32x32x16_bf16(fa[g % 3][1], qf[2 * g], s1, 0, 0, 0);
                s0 = __builtin_amdgcn_mfma_f32_32x32x16_bf16(fa[g % 3][2], qf[2 * g + 1], s0, 0, 0, 0);
                s1 = __builtin_amdgcn_mfma_f32_32x32x16_bf16(fa[g % 3][3], qf[2 * g + 1], s1, 0, 0, 0);
                __builtin_amdgcn_sched_barrier(0);
            }
#undef ATT_RK
        }
        u32x4 fv[3][4];
        const LAS unsigned char* vbase = Vs + r * 144 + 16 * hh;
#define ATT_RV(kk, bf) do { _Pragma("unroll") for (int db = 0; db < 4; ++db) fv[bf][db] = *(const LAS u32x4*)(vbase + db * (32 * 144) + (kk) * 32); } while (0)
        ATT_RV(0, 0); ATT_RV(1, 1);
        if (kt == 64) {
#pragma unroll
            for (int j = 0; j < 16; ++j) { const int key = (j & 3) + 8 * (j >> 2) + 4 * hh;
                if (key >= 16) s0[j] = -1e30f; s1[j] = -1e30f; }
        }
        float mx = fmaxf(s0[0], s1[0]);
#pragma unroll
        for (int j = 1; j < 16; ++j) mx = fmaxf(mx, fmaxf(s0[j], s1[j]));
        mx = fmaxf(mx, shx(mx, lane, 32));
        if (__builtin_amdgcn_ballot_w64(fabsf(mx - (-28.0f)) > 36.0f) != 0ull) {
            const float shift = mx < -64.0f ? mx : fmaxf(mx, 0.f), alpha = __builtin_amdgcn_exp2f(-shift);
            mrun += shift; lrun *= alpha;
#pragma unroll
            for (int j = 0; j < 16; ++j) { s0[j] -= shift; s1[j] -= shift; }
#pragma unroll
            for (int i = 0; i < 4; ++i)
#pragma unroll
                for (int j = 0; j < 16; ++j) oacc[i][j] *= alpha;
        }
        { f32x2 ls2 = (f32x2){0.f, 0.f};
#pragma unroll
          for (int j = 0; j < 16; ++j) { s0[j] = __builtin_amdgcn_exp2f(s0[j]); s1[j] = __builtin_amdgcn_exp2f(s1[j]); ls2 += (f32x2){s0[j], s1[j]}; }
          lrun += ls2[0] + ls2[1]; }
        bf16x8 pf[4];
        { u32x4 t;
          t.x = cvtpk(s0[0], s0[1]); t.y = cvtpk(s0[2], s0[3]); t.z = cvtpk(s0[4], s0[5]); t.w = cvtpk(s0[6], s0[7]); pf[0] = __builtin_bit_cast(bf16x8, t);
          t.x = cvtpk(s0[8], s0[9]); t.y = cvtpk(s0[10], s0[11]); t.z = cvtpk(s0[12], s0[13]); t.w = cvtpk(s0[14], s0[15]); pf[1] = __builtin_bit_cast(bf16x8, t);
          t.x = cvtpk(s1[0], s1[1]); t.y = cvtpk(s1[2], s1[3]); t.z = cvtpk(s1[4], s1[5]); t.w = cvtpk(s1[6], s1[7]); pf[2] = __builtin_bit_cast(bf16x8, t);
          t.x = cvtpk(s1[8], s1[9]); t.y = cvtpk(s1[10], s1[11]); t.z = cvtpk(s1[12], s1[13]); t.w = cvtpk(s1[14], s1[15]); pf[3] = __builtin_bit_cast(bf16x8, t); }
        {
#pragma unroll
            for (int kk = 0; kk < 4; ++kk) {
                if (kk + 2 < 4) ATT_RV(kk + 2, (kk + 2) % 3);
                __builtin_amdgcn_sched_barrier(0);
#pragma unroll
                for (int db = 0; db < 4; ++db) oacc[db] = __builtin_amdgcn_mfma_f32_32x32x16_bf16(__builtin_bit_cast(bf16x8, fv[kk % 3][db]), pf[kk], oacc[db], 0, 0, 0);
                __builtin_amdgcn_sched_barrier(0);
            }
#undef ATT_RV
        }
    }
#undef ATT_LOAD
#undef ATT_STORE
    lrun += shx(lrun, lane, 32);
    const float inv = 1.f / lrun;
    bf16_t* orow = O + (size_t)(b * SEQ + qb * 256 + wave * 32 + r) * 1024 + h * 128;
#pragma unroll
    for (int db = 0; db < 4; ++db)
#pragma unroll
        for (int i4 = 0; i4 < 4; ++i4) { u32x2 w; w.x = pk2(oacc[db][4 * i4] * inv, oacc[db][4 * i4 + 1] * inv); w.y = pk2(oacc[db][4 * i4 + 2] * inv, oacc[db][4 * i4 + 3] * inv);
            *(u32x2*)(orow + 32 * db + 8 * i4 + 4 * hh) = w; }
}

__device__ __forceinline__ void ml_table_task(const float* gates, float* tab, int b, int h, int dir, int st, int lane) {
    const int l5 = lane & 31, tk = dir ? 31 - l5 : l5;
    const int rb = dir ? b * SEQ + (127 - st) * 32 : (st == 0 ? TR + b * 16 - 16 : b * SEQ + (st - 1) * 32);
    const bool valid = !(dir == 0 && st == 0 && tk < 16);
    float li = -1e30f, lf = 0.f;
    if (valid) { li = gates[(size_t)(rb + tk) * 16 + dir * 8 + h]; lf = gates[(size_t)(rb + tk) * 16 + dir * 8 + 4 + h]; }
    float bs = lf;
#pragma unroll
    for (int o = 1; o < 32; o <<= 1) { const float t = shl(bs, lane - o); if (l5 >= o) bs += t; }
    const float a = li - bs; float pm = a;
#pragma unroll
    for (int o = 1; o < 32; o <<= 1) { const float t = shl(pm, lane - o); if (l5 >= o) pm = fmaxf(pm, t); }
    float* T = tab + (size_t)st * 128;
    T[tk] = a; T[32 + tk] = pm; T[64 + tk] = bs;
    if (l5 == 31) { T[96] = bs; T[97] = pm; }
}
constexpr int MLB = 57344, ML_Q = 0, ML_K = 16384, ML_KT = 32768, ML_VT = 49152, ML_A = 114688, ML_SC = 117248;
__device__ __forceinline__ void dma16(const void* g, LAS unsigned char* l) { __builtin_amdgcn_global_load_lds((const unsigned*)g, (LAS unsigned*)l, 16, 0, 0); }
__device__ __forceinline__ void mlstm_unit(LAS unsigned char* lds, const bf16_t* mq, const bf16_t* mk, const bf16_t* mkT, const bf16_t* mvT, const float* gates, bf16_t* hout, float* tab, const void* zero16, int b, int h, int dir, int vh, int wave_u) {
    const int lane = lane_id_v(); const int tid = wave_u * 64 + lane;
    const int wave = wave_u;
    LAS float* SC = (LAS float*)(lds + ML_SC);
    LAS float* sa = SC; LAS float* spm = SC + 32; LAS float* sbb = SC + 64; LAS float* swt = SC + 96; LAS float* sei = SC + 128; LAS float* swc = SC + 160;
    LAS float* qnv = SC + 192; LAS float* rs = SC + 224; LAS float* nvec = SC + 288;
    const char* mqB = (const char*)(mq + (size_t)h * MR * 256); const char* mkB = (const char*)(mk + (size_t)h * MR * 256);
    const char* mkTB = (const char*)(mkT + (size_t)h * 256 * MR); const char* mvTB = (const char*)(mvT + ((size_t)h * 256 + vh * 128) * MR);
    const int nsteps = dir ? 128 : 129;
#define ML_RB(st) (dir ? b * SEQ + (127 - (st)) * 32 : ((st) == 0 ? TR + b * 16 - 16 : b * SEQ + ((st) - 1) * 32))
#define ML_META(st) (dir == 0 && (st) == 0)
    f32x4 Cacc[16];
#pragma unroll
    for (int i = 0; i < 16; ++i) Cacc[i] = (f32x4){0.f, 0.f, 0.f, 0.f};
    if (tid < 256) nvec[tid] = 0.f;
    __syncthreads();
#define ML_DMA(st, bf) do { const int rb_ = ML_RB(st); const bool meta_ = ML_META(st); LAS unsigned char* base_ = lds + (bf) * MLB; \
        _Pragma("unroll") for (int i = 0; i < 2; ++i) { const int q_ = wave * 2 + i, row = 2 * q_ + (lane_o >> 5), cs = (lane_o & 31) ^ (row & 15); \
            const bool ok = !meta_ || row >= 16; const size_t off = (size_t)(rb_ + row) * 512 + cs * 16; \
            dma16(ok ? (const void*)(mqB + off) : zero16, base_ + ML_Q + q_ * 1024); dma16(ok ? (const void*)(mkB + off) : zero16, base_ + ML_K + q_ * 1024); } \
        _Pragma("unroll") for (int i = 0; i < 2; ++i) { const int q_ = wave * 2 + i, d = 16 * q_ + (lane_o >> 2), cs = (lane_o & 3) ^ ((d >> 2) & 3); \
            const bool ok = !meta_ || cs >= 2; dma16(ok ? (const void*)(mkTB + ((size_t)d * MR + rb_ + cs * 8) * 2) : zero16, base_ + ML_KT + q_ * 1024); } \
        { const int q_ = wave, v = 16 * q_ + (lane_o >> 2), cs = (lane_o & 3) ^ ((v >> 2) & 3); \
            const bool ok = !meta_ || cs >= 2; dma16(ok ? (const void*)(mvTB + ((size_t)v * MR + rb_ + cs * 8) * 2) : zero16, base_ + ML_VT + q_ * 1024); } } while (0)
    float mstate = 0.f;
    float bL = tab[96], amax = tab[97];
    if (tid < 32) { sa[tid] = tab[tid]; spm[tid] = tab[32 + tid]; sbb[tid] = tab[64 + tid]; }
    { const int lane_o = lane; ML_DMA(0, 0); }
    asm volatile("s_waitcnt vmcnt(0)" ::: "memory");
    __syncthreads();
    for (int st = 0; st < nsteps; ++st) {
        const int lane_o = lane;
        const int frl = lane_o & 15, fql = lane_o >> 4, tidl = wave * 64 + lane_o;
        const int cur = st & 1; LAS unsigned char* B_ = lds + cur * MLB;
        float na = 0.f, npm = 0.f, nbb = 0.f, nbL = 0.f, namax = 0.f;
        if (st + 1 < nsteps) { const float* Tn = tab + (size_t)(st + 1) * 128; nbL = Tn[96]; namax = Tn[97]; if (tidl < 32) { na = Tn[tidl]; npm = Tn[32 + tidl]; nbb = Tn[64 + tidl]; } }
        asm volatile("" ::: "memory");
        if (st + 1 < nsteps) ML_DMA(st + 1, cur ^ 1);
        const float mrel = fmaxf(mstate, amax), decay = __expf(mstate - mrel);
        if (tidl < 32) { const float Mt = fmaxf(mstate, spm[tidl]); swt[tidl] = __expf(mstate - Mt); sei[tidl] = __expf(-(sbb[tidl] + Mt)); swc[tidl] = __expf(sa[tidl] - mrel); }
        if (wave < 4) { const int si = wave >> 1, tj = wave & 1;
            const bool skip = dir ? (si < tj) : (si > tj);
            f32x4 acc = (f32x4){0.f, 0.f, 0.f, 0.f};
            if (!skip) {
#pragma unroll
                for (int kk = 0; kk < 8; ++kk) { const int cs = ((4 * kk + fql) ^ frl) * 16;
                    const bf16x8 a = *(const LAS bf16x8*)(B_ + ML_K + (16 * si + frl) * 512 + cs);
                    const bf16x8 bq = *(const LAS bf16x8*)(B_ + ML_Q + (16 * tj + frl) * 512 + cs);
                    acc = __builtin_amdgcn_mfma_f32_16x16x32_bf16(a, bq, acc, 0, 0, 0);
                }
            }
            const int t = 16 * tj + frl; const float Mt = fmaxf(mstate, spm[t]); float ps = 0.f; float o[4];
            const f32x4 sa4 = *(const LAS f32x4*)(sa + 16 * si + 4 * fql);
#pragma unroll
            for (int j = 0; j < 4; ++j) { const int s_ = 16 * si + 4 * fql + j; const bool ok = !skip && (dir ? (s_ >= t) : (s_ <= t));
                o[j] = ok ? __expf(sa4[j] - Mt) * acc[j] : 0.f; ps += o[j]; }
            u32x2 w; w.x = cvtpk(o[0], o[1]); w.y = cvtpk(o[2], o[3]);
            *(LAS u32x2*)(lds + ML_A + t * 80 + (16 * si + 4 * fql) * 2) = w;
            ps += shx(ps, lane_o, 16); ps += shx(ps, lane_o, 32);
            if (fql == 0) rs[si * 32 + t] = ps; }
        if (wave >= 4) { const int t2 = (tidl - 256) >> 3, part = tidl & 7; float dsum = 0.f;
#pragma unroll
          for (int i = 0; i < 4; ++i) { const u32x4 qv = *(const LAS u32x4*)(B_ + ML_Q + t2 * 512 + (((4 * part + i) ^ (t2 & 15)) * 16)); const LAS float* nn = nvec + part * 32 + i * 8;
              dsum += bflo(qv.x) * nn[0] + bfhi(qv.x) * nn[1] + bflo(qv.y) * nn[2] + bfhi(qv.y) * nn[3] + bflo(qv.z) * nn[4] + bfhi(qv.z) * nn[5] + bflo(qv.w) * nn[6] + bfhi(qv.w) * nn[7]; }
          dsum += shx(dsum, lane_o, 1); dsum += shx(dsum, lane_o, 2); dsum += shx(dsum, lane_o, 4);
          if (part == 0) qnv[t2] = dsum; }
        f32x4 num[2];
#pragma unroll
        for (int ti = 0; ti < 2; ++ti) num[ti] = (f32x4){0.f, 0.f, 0.f, 0.f};
#pragma unroll
        for (int i = 0; i < 8; ++i) {
            u32x4 cb; cb.x = cvtpk(Cacc[2 * i][0], Cacc[2 * i][1]); cb.y = cvtpk(Cacc[2 * i][2], Cacc[2 * i][3]); cb.z = cvtpk(Cacc[2 * i + 1][0], Cacc[2 * i + 1][1]); cb.w = cvtpk(Cacc[2 * i + 1][2], Cacc[2 * i + 1][3]);
            const bf16x8 bfr = __builtin_bit_cast(bf16x8, cb);
            const int c0s = ((4 * i + fql) ^ frl) * 16;
#pragma unroll
            for (int ti = 0; ti < 2; ++ti) {
                const bf16x8 qa = *(const LAS bf16x8*)(B_ + ML_Q + (16 * ti + frl) * 512 + c0s);
                num[ti] = __builtin_amdgcn_mfma_f32_16x16x32_bf16(qa, bfr, num[ti], 0, 0, 0);
            }
        }
        asm volatile("s_waitcnt lgkmcnt(0)" ::: "memory");
        __builtin_amdgcn_s_barrier();
        asm volatile("" ::: "memory");
        bf16x8 vfr, vfw;
        { const int v = 16 * wave + frl;
            const u32x4 raw = *(const LAS u32x4*)(B_ + ML_VT + v * 64 + ((fql ^ ((v >> 2) & 3)) * 16));
            vfr = __builtin_bit_cast(bf16x8, raw);
            const LAS float* w = swc + 8 * fql; u32x4 sc;
            sc.x = cvtpk(bflo(raw.x) * w[0], bfhi(raw.x) * w[1]); sc.y = cvtpk(bflo(raw.y) * w[2], bfhi(raw.y) * w[3]); sc.z = cvtpk(bflo(raw.z) * w[4], bfhi(raw.z) * w[5]); sc.w = cvtpk(bflo(raw.w) * w[6], bfhi(raw.w) * w[7]);
            vfw = __builtin_bit_cast(bf16x8, sc); }
#pragma unroll
        for (int ti = 0; ti < 2; ++ti) {
            num[ti] = num[ti] * *(const LAS f32x4*)(swt + 16 * ti + 4 * fql);
            const bf16x8 a = *(const LAS bf16x8*)(lds + ML_A + (16 * ti + frl) * 80 + fql * 16);
            num[ti] = __builtin_amdgcn_mfma_f32_16x16x32_bf16(a, vfr, num[ti], 0, 0, 0);
        }
        if (!ML_META(st)) { bf16_t* hb_ = hout + (size_t)ML_RB(st) * 1024 + h * 256 + vh * 128 + 16 * wave;
#pragma unroll
            for (int ti = 0; ti < 2; ++ti) { const int t0 = 16 * ti + 4 * fql;
                const f32x4 den = *(const LAS f32x4*)(rs + t0) + *(const LAS f32x4*)(rs + 32 + t0) + *(const LAS f32x4*)(swt + t0) * *(const LAS f32x4*)(qnv + t0);
                const f32x4 fl = *(const LAS f32x4*)(sei + t0);
#pragma unroll
                for (int j = 0; j < 4; ++j) { const float hv = num[ti][j] * __builtin_amdgcn_rcpf(fmaxf(fabsf(den[j]), fl[j]));
                    hb_[(unsigned)((t0 + j) * 1024 + frl)] = (bf16_t)(cvtpk(hv, 0.f) & 0xffffu); } }
        }
#pragma unroll
        for (int dt = 0; dt < 16; ++dt) { const int d = 16 * dt + frl;
            Cacc[dt] = Cacc[dt] * decay;
            const bf16x8 a = *(const LAS bf16x8*)(B_ + ML_KT + d * 64 + ((fql ^ ((d >> 2) & 3)) * 16));
            Cacc[dt] = __builtin_amdgcn_mfma_f32_16x16x32_bf16(a, vfw, Cacc[dt], 0, 0, 0);
        }
        if (tidl < 256) { float sum = 0.f;
#pragma unroll
            for (int i = 0; i < 4; ++i) { const u32x4 kv = *(const LAS u32x4*)(B_ + ML_KT + tidl * 64 + ((i ^ ((tidl >> 2) & 3)) * 16)); const LAS float* w = swc + 8 * i;
                sum += bflo(kv.x) * w[0] + bfhi(kv.x) * w[1] + bflo(kv.y) * w[2] + bfhi(kv.y) * w[3] + bflo(kv.z) * w[4] + bfhi(kv.z) * w[5] + bflo(kv.w) * w[6] + bfhi(kv.w) * w[7]; }
            const int pd = (tidl & ~31) | perm_qk(tidl & 31);
            nvec[pd] = decay * nvec[pd] + sum; }
        asm volatile("s_waitcnt vmcnt(0)" ::: "memory");
        mstate = bL + mrel; bL = nbL; amax = namax;
        if (st + 1 < nsteps && tidl < 32) { sa[tidl] = na; spm[tidl] = npm; sbb[tidl] = nbb; }
        __syncthreads();
    }
#undef ML_DMA
#undef ML_RB
#undef ML_META
}

__device__ __forceinline__ f32x4 skinny16(const bf16_t* A, int lda, const bf16_t* Bt, int ldb, int K, int fr, int fq) {
    f32x4 acc0 = (f32x4){0.f, 0.f, 0.f, 0.f}, acc1 = (f32x4){0.f, 0.f, 0.f, 0.f};
    const bf16_t* ap = A + (size_t)fr * lda + 8 * fq; const bf16_t* bp = Bt + (size_t)fr * ldb + 8 * fq;
#pragma unroll 4
    for (int k = 0; k < K; k += 64) {
        const bf16x8 a0 = *(const bf16x8*)(ap + k), b0 = *(const bf16x8*)(bp + k), a1 = *(const bf16x8*)(ap + k + 32), b1 = *(const bf16x8*)(bp + k + 32);
        acc0 = __builtin_amdgcn_mfma_f32_16x16x32_bf16(a0, b0, acc0, 0, 0, 0);
        acc1 = __builtin_amdgcn_mfma_f32_16x16x32_bf16(a1, b1, acc1, 0, 0, 0);
    }
    return acc0 + acc1;
}

#define XB_TMO      128
#define XB_XCNT(j)  (256  + 64 * (j))
#define XB_XSUB(j)  (1280 + 64 * (j))
#define XB_XGEN(j)  (2304 + 64 * (j))
#define XB_TOP      3328
#define XB_TOPGEN   3392
#define XCD_BAR_WORDS 3456
#define XB_SPIN_CAP (1u << 18)

__device__ __forceinline__ unsigned xb_ld(unsigned* p)              { return __hip_atomic_load(p, __ATOMIC_RELAXED, __HIP_MEMORY_SCOPE_AGENT); }
__device__ __forceinline__ unsigned xb_add(unsigned* p, unsigned v) { return __hip_atomic_fetch_add(p, v, __ATOMIC_RELAXED, __HIP_MEMORY_SCOPE_AGENT); }
__device__ __forceinline__ unsigned xb_xcc_id() { return (unsigned)__builtin_amdgcn_s_getreg((3 << 11) | 20) & 0xFu; }
#define XB_SPIN(cond, bar) do { unsigned _sp = 0; while (cond) { __builtin_amdgcn_s_sleep(1); \
    if ((++_sp & 255u) == 0u) { if (xb_ld(&(bar)[XB_TMO])) break; if (_sp > XB_SPIN_CAP) { atomicAdd(&(bar)[XB_TMO], 1u); break; } } } } while (0)

struct XcdBarrier {
    unsigned* bar; unsigned x;
    volatile LAS unsigned* st;
};

__device__ __forceinline__ XcdBarrier xcd_barrier_post(unsigned* bar, volatile LAS unsigned* st) {
    XcdBarrier b; b.bar = bar; b.x = xb_xcc_id(); b.st = st;
    if (threadIdx.x == 0) (void)xb_add(&bar[XB_XCNT(b.x)], 1u);
    return b;
}
__device__ __forceinline__ void xcd_barrier_complete(unsigned* bar, unsigned x, unsigned& nloc, unsigned& nx) {
    const unsigned G = gridDim.x * gridDim.y * gridDim.z;
    unsigned sum, cnt, mine, sp = 0u;
    for (;;) {
        sum = 0u; cnt = 0u; mine = 0u;
#pragma unroll
        for (unsigned j = 0; j < 16; ++j) { const unsigned c = xb_ld(&bar[XB_XCNT(j)]); sum += c; cnt += (c > 0u) ? 1u : 0u; mine = (j == x) ? c : mine; }
        if (sum == G) break;
        __builtin_amdgcn_s_sleep(1);
        if ((++sp & 255u) == 0u) { if (xb_ld(&bar[XB_TMO])) break; if (sp > XB_SPIN_CAP) { atomicAdd(&bar[XB_TMO], 1u); break; } }
    }
    nloc = mine > 0u ? mine : 1u; nx = cnt > 0u ? cnt : 1u;
}

__device__ __forceinline__ void xcd_barrier(const XcdBarrier& b) {
    asm volatile("s_waitcnt vmcnt(0)" ::: "memory");
    __syncthreads();
    if (threadIdx.x == 0) {
        unsigned* bar = b.bar;
        __builtin_amdgcn_s_waitcnt(0);
        unsigned nloc = b.st[0], nx = b.st[1];
        if (nloc == 0u) { xcd_barrier_complete(bar, b.x, nloc, nx); b.st[0] = nloc; b.st[1] = nx; }
        const unsigned old = xb_add(&bar[XB_XSUB(b.x)], 1u);
        const unsigned gen = old / nloc;
        if (old + 1u == (gen + 1u) * nloc) {
            __builtin_amdgcn_fence(__ATOMIC_RELEASE, "agent");
            asm volatile("s_waitcnt vmcnt(0)" ::: "memory");
            const unsigned og = xb_add(&bar[XB_TOP], 1u);
            const unsigned tg = og / nx;
            if (og + 1u == (tg + 1u) * nx) xb_add(&bar[XB_TOPGEN], 1u);
            else XB_SPIN(xb_ld(&bar[XB_TOPGEN]) == tg, bar);
            __builtin_amdgcn_fence(__ATOMIC_ACQUIRE, "agent");
            xb_add(&bar[XB_XGEN(b.x)], 1u);
            asm volatile("s_waitcnt vmcnt(0)" ::: "memory");
        } else {
            XB_SPIN(xb_ld(&bar[XB_XGEN(b.x)]) == gen, bar);
            __builtin_amdgcn_fence(__ATOMIC_ACQUIRE, "agent");
            asm volatile("s_waitcnt vmcnt(0)" ::: "memory");
        }
    }
    __syncthreads();
}

__global__ void __launch_bounds__(NTHR, 2) fwd_mega(Args args) {
    extern __shared__ __attribute__((aligned(16))) unsigned char lds_raw[];
    LAS unsigned char* lds = (LAS unsigned char*)lds_raw;
    cg::grid_group grid = cg::this_grid();
    const int G = gridDim.x;
    if (threadIdx.x < 2) ((volatile LAS unsigned*)(lds + 140016))[threadIdx.x] = 0u;
    __syncthreads();
    XcdBarrier xbar = xcd_barrier_post((unsigned*)(args.wsp + WS_BAR), (volatile LAS unsigned*)(lds + 140016));
    if (gridDim.x == 0x7fffffffu) grid.sync();
    const int wave_u = __builtin_amdgcn_readfirstlane((int)(threadIdx.x >> 6));
#define PHASE_VARS int tid = wave_u * 64 + lane_id_v(); const int lane = tid & 63, wave = tid >> 6, gw = blockIdx.x * 8 + wave, NGW = G * 8; LAS float* scr = (LAS float*)(lds + wave * 16384); (void)lane; (void)gw; (void)NGW; (void)scr;
#define ws (args.wsp)
#define ctl ((unsigned*)(args.wsp + WS_CTL))
#define rope ((f32x2*)(args.wsp + WS_ROPE))
#define zmeta ((float*)(args.wsp + WS_ZMETA))
#define h0 ((bf16_t*)(args.wsp + WS_H0))
#define h1 ((bf16_t*)(args.wsp + WS_H1))
#define h2 ((bf16_t*)(args.wsp + WS_H2))
#define Gb ((bf16_t*)(args.wsp + WS_G))
#define ub ((bf16_t*)(args.wsp + WS_U))
#define qn ((bf16_t*)(args.wsp + WS_QN))
#define kvn ((bf16_t*)(args.wsp + WS_KVN))
#define xc ((bf16_t*)(args.wsp + WS_XC))
#define gates ((float*)(args.wsp + WS_GATES))
#define Kn ((bf16_t*)(args.wsp + WS_KN))
#define Vt ((bf16_t*)(args.wsp + WS_VT))
#define Kr ((bf16_t*)(args.wsp + WS_KROPE))
#define oatt ((bf16_t*)(args.wsp + WS_OATT))
#define mkT ((bf16_t*)(args.wsp + WS_MKT))
#define mq ((bf16_t*)(args.wsp + WS_MQ))
#define mk ((bf16_t*)(args.wsp + WS_MK))
#define mvT ((bf16_t*)(args.wsp + WS_MVT))
#define ycat ((bf16_t*)(args.wsp + WS_YCAT))
#define Qb ((bf16_t*)((unsigned char*)args.out + DO_Q))
#define hf ((bf16_t*)((unsigned char*)args.out + DO_HF))
#define hb ((bf16_t*)((unsigned char*)args.out + DO_HB))

    {
        PHASE_VARS
        ffn_weights(args.in[I_F1G], args.in[I_F1U], args.in[I_F1D], ws, scr, gw, NGW, lane);
        constexpr int N_WIN = 32 * 90, N_WUQ = 8 * 48, N_WKV = 4 * 64, N_M = 3 * 4 * 4 * 8, N_WOUT = 32 * 64;
        for (int it = gw; it < N_WIN + N_WUQ + N_WKV + N_M + N_WOUT; it += NGW) {
            int r = it;
            if (r < N_WIN) { const int kb = r / 90, nb = r % 90; tr_item(args.in[I_WIN], 2880, (bf16_t*)(ws + WS_WIN), DM, nb * 32, kb * 64, nb * 32, scr, lane, 1.f); continue; } r -= N_WIN;
            if (r < N_WUQ) { const int kb = r / 48, nb = r % 48, n0 = nb * 32, hq = n0 / 192, d0 = n0 % 192; int dst;
                if (d0 < 128) dst = hq * 128 + d0; else { const int p = hq * 32; dst = 1024 + (p >> 7) * 256 + (d0 >= 160 ? 128 : 0) + (p & 127); }
                tr_item(args.in[I_WUQ], 1536, (bf16_t*)(ws + WS_WUQ), 512, dst, kb * 64, n0, scr, lane, 1.f); continue; } r -= N_WUQ;
            if (r < N_WKV) { const int kb = r / 64, nb = r % 64, n0 = nb * 32, hk = n0 >> 8, c0 = n0 & 255;
                if (c0 < 128) tr_item(args.in[I_WUKV], 2048, (bf16_t*)(ws + WS_WK), 256, hk * 128 + c0, kb * 64, n0, scr, lane, 1.f);
                else tr_item(args.in[I_WUKV], 2048, (bf16_t*)(ws + WS_WV), 256, hk * 128 + c0 - 128, kb * 64, n0, scr, lane, 1.f);
                continue; } r -= N_WKV;
            if (r < N_M) { const int mat = r / 128, hm = (r % 128) / 32, q = r % 32, kb = q / 8, nb = q % 8;
                const float* src = args.in[I_MWQ + mat] + (size_t)hm * 65536;
                bf16_t* dst = (bf16_t*)(ws + (mat == 0 ? WS_WMQ : mat == 1 ? WS_WMK : WS_WMV)) + (size_t)hm * 65536;
                tr_item(src, 256, dst, 256, nb * 32, kb * 64, nb * 32, scr, lane, mat == 1 ? 0.0625f : 1.f, mat < 2);
                if (mat == 1) tr_item(src, 256, (bf16_t*)(ws + WS_WMKN) + (size_t)hm * 65536, 256, nb * 32, kb * 64, nb * 32, scr, lane, 0.0625f);
                continue; } r -= N_M;
            { const int kb = r / 64, nb = r % 64; tr_item(args.in[I_WOUT], DM, (bf16_t*)(ws + WS_WOUT), DM, nb * 32, kb * 64, nb * 32, scr, lane, 1.f); }
        }
        for (int row = gw; row < MR; row += NGW) {
            const float* src = row < TR ? args.in[I_X] + (size_t)row * DM : (row < MROWS ? args.in[I_META] + (size_t)((row - TR) & 15) * DM : nullptr);
#pragma unroll
            for (int j = 0; j < 4; ++j) { const int c = 8 * (lane + 64 * j); u32x4 w = (u32x4){0, 0, 0, 0};
                if (src) { const f32x4 a = __builtin_nontemporal_load((const f32x4*)(src + c)), bq = __builtin_nontemporal_load((const f32x4*)(src + c + 4)); w.x = pk2(a[0], a[1]); w.y = pk2(a[2], a[3]); w.z = pk2(bq[0], bq[1]); w.w = pk2(bq[2], bq[3]); }
                *(u32x4*)(h0 + (size_t)row * DM + c) = w; }
        }
        for (int i = blockIdx.x * NTHR + tid; i < 16 * 2048; i += G * NTHR) { const int gi = i >> 11, k = i & 2047; ((bf16_t*)(ws + WS_WGT))[i] = (bf16_t)f2bf(args.in[I_WG][(size_t)k * 16 + gi]); }
        for (int i = blockIdx.x * NTHR + tid; i < LTOT * 32; i += G * NTHR) { const int pos = i >> 5, k = i & 31;
            const float inv = powf(10000.f, -(float)(2 * k) / 64.f), ang = (float)pos * inv; rope[i] = (f32x2){cosf(ang), sinf(ang)}; }
    }
    xcd_barrier(xbar);
    { pg8::Gemm g{DM, DM, DM}; pg8::Sched S; S.init(TR / 256, 44, 1, G, blockIdx.x, h0, ws + WS_WGU, 0, 0, 1, DM, DM);
      pg8::EpiSwiGLU E{Gb}; pg8::gemm_phase<GEMM_SP2, GEMM_ALIGN>(lds, g, S, E, wave_u); }
    { PHASE_VARS const int fr = lane & 15, fq = lane >> 4; LAS float* red = (LAS float*)lds;
      for (int bu = blockIdx.x; bu < FF / 16; bu += G) { const int f0 = bu * 16, r0 = (f0 >> 7) * 256 + (f0 & 127), k0 = wave * (DM / 8);
          const f32x4 ag = skinny16(h0 + (size_t)TR * DM + k0, DM, (const bf16_t*)(ws + WS_WGU) + (size_t)r0 * DM + k0, DM, DM / 8, fr, fq);
          const f32x4 au = skinny16(h0 + (size_t)TR * DM + k0, DM, (const bf16_t*)(ws + WS_WGU) + (size_t)(r0 + 128) * DM + k0, DM, DM / 8, fr, fq);
#pragma unroll
          for (int j = 0; j < 4; ++j) { red[(wave * 16 + 4 * fq + j) * 16 + fr] = ag[j]; red[2048 + (wave * 16 + 4 * fq + j) * 16 + fr] = au[j]; }
          __syncthreads();
          if (tid < 256) { float g = 0.f, u = 0.f;
#pragma unroll
              for (int w = 0; w < 8; ++w) { g += red[w * 256 + tid]; u += red[2048 + w * 256 + tid]; }
              Gb[(size_t)(TR + (tid >> 4)) * FF + f0 + (tid & 15)] = (bf16_t)f2bf(siluf(g) * u); }
          __syncthreads(); } }
    xcd_barrier(xbar);
    { pg8::Gemm g{FF, FF, FF}; pg8::Sched S; S.init(TR / 256, 8, 1, G, blockIdx.x, Gb, ws + WS_WD, 0, 0, 1, FF, FF);
      pg8::EpiResid E{h0, (bf16_t*)(ws + WS_RM), 0.5f}; pg8::gemm_phase<GEMM_SP2, GEMM_ALIGN>(lds, g, S, E, wave_u); }
    { PHASE_VARS const int fr = lane & 15, fq = lane >> 4; LAS float* red = (LAS float*)lds;
      for (int bu = blockIdx.x; bu < DM / 16; bu += G) { const int c0 = bu * 16, k0 = wave * (FF / 8);
          const f32x4 a = skinny16(Gb + (size_t)TR * FF + k0, FF, (const bf16_t*)(ws + WS_WD) + (size_t)c0 * FF + k0, FF, FF / 8, fr, fq);
#pragma unroll
          for (int j = 0; j < 4; ++j) red[(wave * 16 + 4 * fq + j) * 16 + fr] = a[j];
          __syncthreads();
          if (tid < 256) { float v = 0.f;
#pragma unroll
              for (int w = 0; w < 8; ++w) v += red[w * 256 + tid];
              const int m = tid >> 4, c = c0 + (tid & 15); v = ALPHA * bf1(h0[(size_t)(TR + m) * DM + c]) + 0.5f * v;
#pragma unroll
              for (int bb = 0; bb < 4; ++bb) zmeta[(size_t)(bb * 16 + m) * DM + c] = v; }
          __syncthreads(); } }
    xcd_barrier(xbar);
    { PHASE_VARS
    for (int row = gw; row < MROWS; row += NGW) {
        if (row < TR) ln_row_b((const bf16_t*)(ws + WS_RM) + (size_t)row * DM, args.in[I_LN1G], args.in[I_LN1B], h1 + (size_t)row * DM, nullptr, lane);
        else ln_row(zmeta + (size_t)(row - TR) * DM, args.in[I_LN1G], args.in[I_LN1B], h1 + (size_t)row * DM, nullptr, lane); } }
    xcd_barrier(xbar);
    { pg8::Gemm g{DM, DM, DM}; pg8::Sched S; S.init(TR / 256, 12, 1, G, blockIdx.x, h1, ws + WS_WIN, 0, 0, 1, DM, DM);
      pg8::EpiBf16 E{ub, UW, 0, 1 << 30, 1.f}; pg8::gemm_phase<GEMM_SP2, GEMM_ALIGN>(lds, g, S, E, wave_u); }
    { PHASE_VARS const int fr = lane & 15, fq = lane >> 4; LAS float* red = (LAS float*)lds;
      for (int bu = blockIdx.x; bu < 2880 / 16; bu += G) { const int c0 = bu * 16, k0 = wave * (DM / 8);
          const f32x4 a = skinny16(h1 + (size_t)TR * DM + k0, DM, (const bf16_t*)(ws + WS_WIN) + (size_t)c0 * DM + k0, DM, DM / 8, fr, fq);
#pragma unroll
          for (int j = 0; j < 4; ++j) red[(wave * 16 + 4 * fq + j) * 16 + fr] = a[j];
          __syncthreads();
          if (tid < 256) { float v = 0.f;
#pragma unroll
              for (int w = 0; w < 8; ++w) v += red[w * 256 + tid];
              const int m = tid >> 4, c = c0 + (tid & 15); const bf16_t o = (bf16_t)f2bf(v);
#pragma unroll
              for (int bb = 0; bb < 4; ++bb) ub[(size_t)(TR + bb * 16 + m) * UW + c] = o; }
          __syncthreads(); } }
    xcd_barrier(xbar);
    {
        PHASE_VARS
        const float* cw = args.in[I_CW]; const float* cb = args.in[I_CB];
        for (int row = gw; row < MROWS; row += NGW) {
            int b, pos, key; if (row < TR) { b = row >> 12; key = row & 4095; pos = 16 + key; } else { b = (row - TR) >> 4; pos = (row - TR) & 15; key = SEQ + pos; }
            const bf16_t* ur = ub + (size_t)row * UW;
            { const u32x4 v = *(const u32x4*)(ur + 8 * lane); float f[8] = {bflo(v.x), bfhi(v.x), bflo(v.y), bfhi(v.y), bflo(v.z), bfhi(v.z), bflo(v.w), bfhi(v.w)};
              float ss = 0.f;
#pragma unroll
              for (int i = 0; i < 8; ++i) ss += f[i] * f[i];
              const float rms = 1.f / sqrtf(wave_sum(ss) * (1.f / 512.f) + 1e-6f); const float* gq = args.in[I_QNG] + 8 * lane;
              u32x4 w; w.x = pk2(f[0] * rms * gq[0], f[1] * rms * gq[1]); w.y = pk2(f[2] * rms * gq[2], f[3] * rms * gq[3]); w.z = pk2(f[4] * rms * gq[4], f[5] * rms * gq[5]); w.w = pk2(f[6] * rms * gq[6], f[7] * rms * gq[7]);
              *(u32x4*)(qn + (size_t)row * 512 + 8 * lane) = w; }
            { const u32x2 v = *(const u32x2*)(ur + O2 + 4 * lane); float f[4] = {bflo(v.x), bfhi(v.x), bflo(v.y), bfhi(v.y)};
              const float ss = f[0] * f[0] + f[1] * f[1] + f[2] * f[2] + f[3] * f[3];
              const float rms = 1.f / sqrtf(wave_sum(ss) * (1.f / 256.f) + 1e-6f); const float* gk = args.in[I_KVNG] + 4 * lane;
              u32x2 w; w.x = pk2(f[0] * rms * gk[0], f[1] * rms * gk[1]); w.y = pk2(f[2] * rms * gk[2], f[3] * rms * gk[3]);
              *(u32x2*)(kvn + (size_t)row * 256 + 4 * lane) = w; }
            if (lane < 32) { const float x1 = bf1(ur[O3 + lane]), x2 = bf1(ur[O3 + 32 + lane]); const f32x2 cs = rope[pos * 32 + lane];
              bf16_t* kp = Kr + ((size_t)b * LK + key) * 64; kp[lane] = (bf16_t)f2bf(x1 * cs.x - x2 * cs.y); kp[32 + lane] = (bf16_t)f2bf(x2 * cs.x + x1 * cs.y); }
            { float acc[16];
#pragma unroll
              for (int i = 0; i < 16; ++i) acc[i] = cb[16 * lane + i];
#pragma unroll
              for (int t = 0; t < 5; ++t) { const int q = pos - 2 + t;
                  if (q >= 0 && q < LTOT) { const int nr = q < 16 ? TR + b * 16 + q : b * SEQ + q - 16; const bf16_t* xr = ub + (size_t)nr * UW + O4 + 16 * lane;
                      const u32x4 v0 = *(const u32x4*)xr, v1 = *(const u32x4*)(xr + 8); const float* wt = cw + t * 1024 + 16 * lane;
                      acc[0] += wt[0] * bflo(v0.x); acc[1] += wt[1] * bfhi(v0.x); acc[2] += wt[2] * bflo(v0.y); acc[3] += wt[3] * bfhi(v0.y);
                      acc[4] += wt[4] * bflo(v0.z); acc[5] += wt[5] * bfhi(v0.z); acc[6] += wt[6] * bflo(v0.w); acc[7] += wt[7] * bfhi(v0.w);
                      acc[8] += wt[8] * bflo(v1.x); acc[9] += wt[9] * bfhi(v1.x); acc[10] += wt[10] * bflo(v1.y); acc[11] += wt[11] * bfhi(v1.y);
                      acc[12] += wt[12] * bflo(v1.z); acc[13] += wt[13] * bfhi(v1.z); acc[14] += wt[14] * bflo(v1.w); acc[15] += wt[15] * bfhi(v1.w); } }
              u32x4 w0, w1;
              w0.x = pk2(siluf(acc[0]), siluf(acc[1])); w0.y = pk2(siluf(acc[2]), siluf(acc[3])); w0.z = pk2(siluf(acc[4]), siluf(acc[5])); w0.w = pk2(siluf(acc[6]), siluf(acc[7]));
              w1.x = pk2(siluf(acc[8]), siluf(acc[9])); w1.y = pk2(siluf(acc[10]), siluf(acc[11])); w1.z = pk2(siluf(acc[12]), siluf(acc[13])); w1.w = pk2(siluf(acc[14]), siluf(acc[15]));
              *(u32x4*)(xc + (size_t)row * 1024 + 16 * lane) = w0; *(u32x4*)(xc + (size_t)row * 1024 + 16 * lane + 8) = w1; }
        }
        for (int i = blockIdx.x * NTHR + tid; i < 32 * 48 * 128; i += G * NTHR) { const int bh = i / (48 * 128), rem = i % (48 * 128); Kn[((size_t)bh * LK + LTOT) * 128 + rem] = 0; }
        for (int i = blockIdx.x * NTHR + tid; i < 4 * 48 * 64; i += G * NTHR) { const int bb = i / (48 * 64), rem = i % (48 * 64); Kr[((size_t)bb * LK + LTOT) * 64 + rem] = 0; }
        for (int i = blockIdx.x * NTHR + tid; i < 32 * 128 * 48; i += G * NTHR) { const int bhd = i / 48, rem = i % 48; Vt[(size_t)bhd * LK + LTOT + rem] = 0; }
    }
    xcd_barrier(xbar);
    { PHASE_VARS const int fr = lane & 15, fq = lane >> 4; const bf16_t* WgT = (const bf16_t*)(ws + WS_WGT); LAS float* red = (LAS float*)lds;
      for (int bu = blockIdx.x; bu < MROWS / 16; bu += G) { const int r0 = bu * 16;
          const f32x4 a = wave < 4 ? skinny16(xc + (size_t)r0 * 1024 + wave * 256, 1024, WgT + wave * 256, 2048, 256, fr, fq)
                                   : skinny16(ub + (size_t)r0 * UW + O4 + (wave - 4) * 256, UW, WgT + wave * 256, 2048, 256, fr, fq);
#pragma unroll
          for (int j = 0; j < 4; ++j) red[(wave * 16 + 4 * fq + j) * 16 + fr] = a[j];
          __syncthreads();
          if (tid < 256) { float sv = args.in[I_BG][tid & 15];
#pragma unroll
              for (int w = 0; w < 8; ++w) sv += red[w * 256 + tid];
              if (((tid & 15) >> 2) & 1) sv = fminf(sv, 0.f) - log1pf(__expf(-fabsf(sv)));
              gates[(size_t)(r0 + (tid >> 4)) * 16 + (tid & 15)] = sv; }
          __syncthreads(); } }
    xcd_barrier(xbar);
    { PHASE_VARS
      for (int task = gw * 2 + (lane >> 5); task < 32 * 129; task += NGW * 2) { const int sq = task / 129, st = task - sq * 129, dir = sq & 1;
          if (st < (dir ? 128 : 129)) ml_table_task(gates, (float*)(ws + WS_TAB) + (size_t)sq * 129 * 128, sq >> 3, (sq >> 1) & 3, dir, st, lane); } }
    { pg8::Gemm g{512, 512, 512}; pg8::Sched S; S.init(TR / 256, 6, 1, G, blockIdx.x, qn, ws + WS_WUQ, 0, 0, 1, 512, 512);
      pg8::EpiQ E{Qb, rope}; pg8::gemm_phase<false, GEMM_ALIGN>(lds, g, S, E, wave_u); }
    { pg8::Gemm g{256, 256, 256}; pg8::Sched S; S.init(MR / 256, 4, 1, G, (blockIdx.x + 128) % G, kvn, ws + WS_WK, 0, 0, 1, 256, 256);
      pg8::EpiKn E{Kn}; pg8::gemm_phase<false, GEMM_ALIGN>(lds, g, S, E, wave_u); }
    { pg8::Gemm g{256, 256, 256}; pg8::Sched S; S.init(4, MR / 256, 1, G, (blockIdx.x + 120) % G, ws + WS_WV, kvn, 0, 0, 1, 256, 256);
      pg8::EpiVt E{Vt}; pg8::gemm_phase<false, GEMM_ALIGN>(lds, g, S, E, wave_u); }
    { pg8::Gemm g{256, 1024, 256}; pg8::Sched S; S.init(MR / 256, 1, 8, G, (blockIdx.x + 112) % G, xc, ws + WS_WMQ, 512, 131072, 4, 1024, 256);
      pg8::EpiBf16 E{mq, 256, (size_t)MR * 256, 1 << 30, 1.f}; pg8::gemm_phase<false, GEMM_ALIGN>(lds, g, S, E, wave_u); }
    { pg8::Gemm g{256, 256, 1024}; pg8::Sched S; S.init(1, MR / 256, 4, G, (blockIdx.x + 104) % G, ws + WS_WMKN, xc, 131072, 512, 4, 256, 1024);
      pg8::EpiBf16 E{mkT, MR, (size_t)256 * MR, 1 << 30, 1.f}; pg8::gemm_phase<false, GEMM_ALIGN>(lds, g, S, E, wave_u); }
    { pg8::Gemm g{256, 256, UW}; pg8::Sched S; S.init(1, MR / 256, 4, G, (blockIdx.x + 96) % G, ws + WS_WMV, ub + O4, 131072, 512, 4, 256, UW);
      pg8::EpiBf16 E{mvT, MR, (size_t)256 * MR, 1 << 30, 1.f}; pg8::gemm_phase<false, GEMM_ALIGN>(lds, g, S, E, wave_u); }
    xcd_barrier(xbar);
    {
        PHASE_VARS
        if (blockIdx.x < 64) { const int uid = blockIdx.x; mlstm_unit(lds, mq, mk, mkT, mvT, gates, ((uid >> 1) & 1) ? hb : hf, (float*)(ws + WS_TAB) + (size_t)(uid >> 1) * 129 * 128, (const void*)(ws + 1024), uid >> 4, (uid >> 2) & 3, (uid >> 1) & 1, uid & 1, wave_u); }
        LAS int* uslot = (LAS int*)(lds + 140000);
        const int tid2 = wave_u * 64 + lane_id_v();
        for (;;) {
            __syncthreads();
            if (tid2 == 0) *uslot = (int)atomicAdd(ctl, 1u);
            __syncthreads();
            const int uid = *uslot;
            if (uid >= 512) break;
            attn_unit(lds, Qb, Kn, Kr, Vt, oatt, uid >> 7, (uid >> 4) & 7, uid & 15, wave_u);
        }
    }
    xcd_barrier(xbar);
    { PHASE_VARS
    for (int row = gw; row < TR; row += NGW) {
        { const bf16_t* op = oatt + (size_t)row * 1024 + 16 * lane; const u32x4 v0 = __builtin_nontemporal_load((const u32x4*)op), v1 = __builtin_nontemporal_load((const u32x4*)(op + 8));
          float f[16] = {bflo(v0.x), bfhi(v0.x), bflo(v0.y), bfhi(v0.y), bflo(v0.z), bfhi(v0.z), bflo(v0.w), bfhi(v0.w), bflo(v1.x), bfhi(v1.x), bflo(v1.y), bfhi(v1.y), bflo(v1.z), bfhi(v1.z), bflo(v1.w), bfhi(v1.w)};
          float ss = 0.f;
#pragma unroll
          for (int i = 0; i < 16; ++i) ss += f[i] * f[i];
          const float rms = 1.f / sqrtf(wave_sum(ss) * (1.f / 1024.f) + 1e-6f); const float* og = args.in[I_AOG] + 16 * lane;
          u32x4 w0, w1;
          w0.x = pk2(f[0] * rms * og[0], f[1] * rms * og[1]); w0.y = pk2(f[2] * rms * og[2], f[3] * rms * og[3]); w0.z = pk2(f[4] * rms * og[4], f[5] * rms * og[5]); w0.w = pk2(f[6] * rms * og[6], f[7] * rms * og[7]);
          w1.x = pk2(f[8] * rms * og[8], f[9] * rms * og[9]); w1.y = pk2(f[10] * rms * og[10], f[11] * rms * og[11]); w1.z = pk2(f[12] * rms * og[12], f[13] * rms * og[13]); w1.w = pk2(f[14] * rms * og[14], f[15] * rms * og[15]);
          *(u32x4*)(ycat + (size_t)row * DM + 16 * lane) = w0; *(u32x4*)(ycat + (size_t)row * DM + 16 * lane + 8) = w1; }
#pragma unroll
        for (int hd = 0; hd < 4; ++hd) { const int c = hd * 256 + 4 * lane;
            const u32x2 a = __builtin_nontemporal_load((const u32x2*)(hf + (size_t)row * 1024 + c)), bq = __builtin_nontemporal_load((const u32x2*)(hb + (size_t)row * 1024 + c)), zz = *(const u32x2*)(ub + (size_t)row * UW + O5 + c), xx = *(const u32x2*)(xc + (size_t)row * 1024 + c);
            float hv[4] = {bflo(a.x) + bflo(bq.x), bfhi(a.x) + bfhi(bq.x), bflo(a.y) + bflo(bq.y), bfhi(a.y) + bfhi(bq.y)};
            const float zf[4] = {bflo(zz.x), bfhi(zz.x), bflo(zz.y), bfhi(zz.y)}, xf[4] = {bflo(xx.x), bfhi(xx.x), bflo(xx.y), bfhi(xx.y)};
#pragma unroll
            for (int i = 0; i < 4; ++i) hv[i] *= sigmf(zf[i]);
            const float mu = wave_sum(hv[0] + hv[1] + hv[2] + hv[3]) * (1.f / 256.f);
            float s2 = 0.f;
#pragma unroll
            for (int i = 0; i < 4; ++i) { hv[i] -= mu; s2 += hv[i] * hv[i]; }
            const float rstd = 1.f / sqrtf(wave_sum(s2) * (1.f / 256.f) + 1e-5f);
            const float* gg = args.in[I_GNG] + c; const float* sk = args.in[I_SKIP] + c;
            u32x2 w; w.x = pk2(hv[0] * rstd * gg[0] + sk[0] * xf[0], hv[1] * rstd * gg[1] + sk[1] * xf[1]); w.y = pk2(hv[2] * rstd * gg[2] + sk[2] * xf[2], hv[3] * rstd * gg[3] + sk[3] * xf[3]);
            *(u32x2*)(ycat + (size_t)row * DM + 1024 + c) = w; }
    } }
    xcd_barrier(xbar);
    { pg8::Gemm g{DM, DM, DM}; pg8::Sched S; S.init(TR / 256, 8, 1, G, blockIdx.x, ycat, ws + WS_WOUT, 0, 0, 1, DM, DM);
      pg8::EpiResid E{h1, (bf16_t*)args.out, 1.0f}; pg8::gemm_phase<GEMM_SP2, GEMM_ALIGN>(lds, g, S, E, wave_u); }
    xcd_barrier(xbar);
    { PHASE_VARS
    for (int row = gw; row < TR; row += NGW) ln_row_b((const bf16_t*)args.out + (size_t)row * DM, args.in[I_LN2G], args.in[I_LN2B], h2 + (size_t)row * DM, nullptr, lane);
    ffn_weights(args.in[I_F2G], args.in[I_F2U], args.in[I_F2D], ws, scr, gw, NGW, lane); }
    xcd_barrier(xbar);
    { pg8::Gemm g{DM, DM, DM}; pg8::Sched S; S.init(TR / 256, 44, 1, G, blockIdx.x, h2, ws + WS_WGU, 0, 0, 1, DM, DM);
      pg8::EpiSwiGLU E{Gb}; pg8::gemm_phase<GEMM_SP2, GEMM_ALIGN>(lds, g, S, E, wave_u); }
    xcd_barrier(xbar);
    { pg8::Gemm g{FF, FF, FF}; pg8::Sched S; S.init(TR / 256, 8, 1, G, blockIdx.x, Gb, ws + WS_WD, 0, 0, 1, FF, FF);
      pg8::EpiResid E{h2, (bf16_t*)(ws + WS_RM), 0.5f}; pg8::gemm_phase<GEMM_SP2, GEMM_ALIGN>(lds, g, S, E, wave_u); }
    xcd_barrier(xbar);
    { PHASE_VARS
    for (int row = gw; row < TR; row += NGW) ln_row_b((const bf16_t*)(ws + WS_RM) + (size_t)row * DM, args.in[I_LN3G], args.in[I_LN3B], nullptr, args.out + (size_t)row * DM, lane); }
}

extern "C" void kernel_launch(void* const* d_in, const int* in_sizes, int n_in, void* d_out, int out_size, void* d_ws, size_t ws_size, hipStream_t stream) {
    static int grid = 0;
    if (grid == 0) {
        if (n_in != 30 || out_size != TR * DM || ws_size < WS_END) { fprintf(stderr, "kernel_launch: unexpected shapes (n_in %d out %d ws %zu need %zu)\n", n_in, out_size, ws_size, (size_t)WS_END); grid = -1; return; }
        int dev = 0, cus = 0, per_cu = 0;
        if (hipGetDevice(&dev) != hipSuccess || hipDeviceGetAttribute(&cus, hipDeviceAttributeMultiprocessorCount, dev) != hipSuccess) { grid = -1; return; }
        if (hipFuncSetAttribute((const void*)fwd_mega, hipFuncAttributeMaxDynamicSharedMemorySize, LDS_BYTES) != hipSuccess) { fprintf(stderr, "hipFuncSetAttribute failed\n"); grid = -1; return; }
        if (hipOccupancyMaxActiveBlocksPerMultiprocessor(&per_cu, (const void*)fwd_mega, NTHR, LDS_BYTES) != hipSuccess || per_cu < 1) fprintf(stderr, "occupancy query: %d\n", per_cu);
        (void)hipGetLastError();
        grid = cus;
        if (grid < 64) { fprintf(stderr, "grid too small\n"); grid = -1; }
    }
    if (grid < 0) return;
    Args a{};
    for (int i = 0; i < 30; ++i) a.in[i] = (const float*)d_in[i];
    a.out = (float*)d_out; a.wsp = (unsigned char*)d_ws;
    (void)hipMemsetAsync(d_ws, 0, 4096 + 16384, stream);
    void* params[] = {&a};
    hipError_t e = hipLaunchCooperativeKernel((const void*)fwd_mega, dim3(grid), dim3(NTHR), params, LDS_BYTES, stream);
    if (e != hipSuccess) fprintf(stderr, "cooperative launch failed: %s (grid %d)\n", hipGetErrorString(e), grid);
}
```
